# Optimizing an MI355X kernel written in HIP

```python
import math
import jax, jax.numpy as jnp
from jax import lax
import numpy as np

D_MODEL = 1024
BATCH = 8
SEQ = 8192
DEPTH = 1

CHUNK = 64
Q_BLOCK = 128
POOL_WINDOWS = (2, 4, 8, 16)
POOL_WIDTH = D_MODEL // 2
POOL_GROUP = POOL_WIDTH // len(POOL_WINDOWS)
N_HEADS = D_MODEL // 128
HEAD_DIM = 64
V_DIM = 2 * HEAD_DIM
ATTN_QK_WIDTH = N_HEADS * 2 * HEAD_DIM
ATTN_V_WIDTH = N_HEADS * V_DIM
N_BRANCH = 2
IN_WIDTH = POOL_WIDTH + 2 * ATTN_QK_WIDTH + ATTN_V_WIDTH + N_BRANCH * D_MODEL
D_FF = 4 * D_MODEL
ROPE_THETA = 500000.0
ROPE_DIM = HEAD_DIM // 4
NORM_EPS = 1e-6
SUBLN_EPS = 1e-5

kernel_name = "hybrid_pool_diffattn_gated_block"


def rms_norm(x, g, eps=NORM_EPS):
    x32 = x.astype(jnp.float32)
    y = x32 * lax.rsqrt(jnp.mean(x32 * x32, axis=-1, keepdims=True) + eps)
    return (y * g.astype(jnp.float32)).astype(x.dtype)


def rope_tables(seq):
    pos = jnp.arange(seq, dtype=jnp.float32)
    inv = ROPE_THETA ** (-jnp.arange(0, ROPE_DIM, 2, dtype=jnp.float32) / ROPE_DIM)
    ang = pos[:, None] * inv[None, :]
    return jnp.cos(ang), jnp.sin(ang)


def partial_rope(t, cos, sin):
    half = ROPE_DIM // 2
    c = cos[None, :, None, None, :].astype(t.dtype)
    s = sin[None, :, None, None, :].astype(t.dtype)
    t1 = t[..., :half]
    t2 = t[..., half:ROPE_DIM]
    return jnp.concatenate([t1 * c - t2 * s, t2 * c + t1 * s, t[..., ROPE_DIM:]], axis=-1)


def multiscale_pool(u, w_group, scale):
    B, S, _ = u.shape
    ug = u.reshape(B, S, len(POOL_WINDOWS), POOL_GROUP)
    t = jnp.arange(1, S + 1, dtype=jnp.float32)
    outs = []
    for gi, w in enumerate(POOL_WINDOWS):
        xg = ug[:, :, gi, :].astype(jnp.float32)
        cs = jnp.cumsum(xg, axis=1)
        cs_prev = jnp.pad(cs, ((0, 0), (w, 0), (0, 0)))[:, :S]
        count = jnp.minimum(t, float(w))
        mean = (cs - cs_prev) / count[None, :, None]
        outs.append((mean - xg).astype(u.dtype))
    pooled = jnp.stack(outs, axis=2)
    mixed = jnp.einsum('bsgp,gpq->bsgq', pooled, w_group)
    return mixed.reshape(B, S, POOL_WIDTH) * scale


def diff_attention(q, k, v, lam):
    B, S = q.shape[0], q.shape[1]
    nb = S // Q_BLOCK
    qb = q.reshape(B, nb, Q_BLOCK, N_HEADS, 2, HEAD_DIM).transpose(1, 0, 2, 3, 4, 5)
    key_chunk = jnp.arange(S) // CHUNK
    scale = HEAD_DIM ** -0.5

    def one_block(args):
        i, qi = args
        q_chunk = (i * Q_BLOCK + jnp.arange(Q_BLOCK)) // CHUNK
        allowed = key_chunk[None, :] <= q_chunk[:, None]
        s = jnp.einsum('bqhcd,bkhcd->bhcqk', qi, k,
                       preferred_element_type=jnp.float32) * scale
        s = jnp.where(allowed, s, -jnp.inf)
        p = jax.nn.softmax(s, axis=-1)
        a = p[:, :, 0] - lam * p[:, :, 1]
        return jnp.einsum('bhqk,bkhe->bqhe', a.astype(v.dtype), v)

    out = lax.map(one_block, (jnp.arange(nb), qb))
    return out.transpose(1, 0, 2, 3, 4).reshape(B, S, N_HEADS, V_DIM)


def setup_inputs(seed: int = 0) -> dict:
    key = jax.random.key(seed)
    ks = jax.random.split(key, 20)
    f32 = jnp.float32
    nrm = lambda k, shp, s: jax.random.normal(k, shp, f32) * s
    L = DEPTH
    return {
        "x": nrm(ks[0], (BATCH, SEQ, D_MODEL), 1.0),
        "w_in": nrm(ks[1], (L, D_MODEL, IN_WIDTH), D_MODEL ** -0.5),
        "b_gate": nrm(ks[2], (L, N_BRANCH, D_MODEL), 0.1),
        "pool_w": nrm(ks[3], (L, len(POOL_WINDOWS), POOL_GROUP, POOL_GROUP), POOL_GROUP ** -0.5),
        "pool_scale": 1.0 + nrm(ks[4], (L, POOL_WIDTH), 0.1),
        "lambda_q1": nrm(ks[5], (L, HEAD_DIM), 0.1),
        "lambda_k1": nrm(ks[6], (L, HEAD_DIM), 0.1),
        "lambda_q2": nrm(ks[7], (L, HEAD_DIM), 0.1),
        "lambda_k2": nrm(ks[8], (L, HEAD_DIM), 0.1),
        "g_subln": 1.0 + nrm(ks[9], (L, V_DIM), 0.1),
        "w_pool_out": nrm(ks[10], (L, POOL_WIDTH, D_MODEL), POOL_WIDTH ** -0.5),
        "w_attn_out": nrm(ks[11], (L, ATTN_V_WIDTH, D_MODEL), ATTN_V_WIDTH ** -0.5),
        "w_o": nrm(ks[12], (L, D_MODEL, D_MODEL), D_MODEL ** -0.5),
        "g_mix": 1.0 + nrm(ks[13], (L, D_MODEL), 0.1),
        "g_mlp": 1.0 + nrm(ks[14], (L, D_MODEL), 0.1),
        "w_up": nrm(ks[15], (L, D_MODEL, D_FF), D_MODEL ** -0.5),
        "w_down": nrm(ks[16], (L, D_FF, D_MODEL), D_FF ** -0.5),
        "g_final": 1.0 + nrm(ks[17], (D_MODEL,), 0.1),
    }


def reference(x, w_in, b_gate, pool_w, pool_scale, lambda_q1, lambda_k1, lambda_q2, lambda_k2,
              g_subln, w_pool_out, w_attn_out, w_o, g_mix, g_mlp, w_up, w_down, g_final):
    B, S, _ = x.shape
    cos, sin = rope_tables(S)
    o1 = POOL_WIDTH
    o2 = o1 + ATTN_QK_WIDTH
    o3 = o2 + ATTN_QK_WIDTH
    o4 = o3 + ATTN_V_WIDTH
    for l in range(DEPTH):
        lambda_init = 0.8 - 0.6 * math.exp(-0.3 * l)
        h = rms_norm(x, g_mix[l])
        proj = h @ w_in[l]
        u_pool = proj[..., :o1]
        q = proj[..., o1:o2].reshape(B, S, N_HEADS, 2, HEAD_DIM)
        k = proj[..., o2:o3].reshape(B, S, N_HEADS, 2, HEAD_DIM)
        v = proj[..., o3:o4].reshape(B, S, N_HEADS, V_DIM)
        gates = jax.nn.sigmoid(proj[..., o4:].reshape(B, S, N_BRANCH, D_MODEL) + b_gate[l])
        y_pool = multiscale_pool(u_pool, pool_w[l], pool_scale[l]) @ w_pool_out[l]
        q = partial_rope(q, cos, sin)
        k = partial_rope(k, cos, sin)
        lam = (jnp.exp(jnp.sum(lambda_q1[l].astype(jnp.float32) * lambda_k1[l].astype(jnp.float32)))
               - jnp.exp(jnp.sum(lambda_q2[l].astype(jnp.float32) * lambda_k2[l].astype(jnp.float32)))
               + lambda_init)
        att = diff_attention(q, k, v, lam)
        att = rms_norm(att, g_subln[l], SUBLN_EPS) * (1.0 - lambda_init)
        y_attn = att.reshape(B, S, ATTN_V_WIDTH) @ w_attn_out[l]
        merged = gates[:, :, 0] * y_pool + gates[:, :, 1] * y_attn
        x = x + merged @ w_o[l]
        h2 = rms_norm(x, g_mlp[l])
        x = x + jnp.square(jax.nn.relu(h2 @ w_up[l])) @ w_down[l]
    return rms_norm(x, g_final)
```

```cpp
#include <hip/hip_runtime.h>
#include <hip/hip_cooperative_groups.h>
#include <cstdio>
#include <cstdint>
namespace cg = cooperative_groups;
#ifndef PROBE_DUP
#define PROBE_DUP 0
#endif

constexpr int BATCH = 8, SEQ = 8192, DM = 1024, MTOK = BATCH * SEQ;
constexpr int POOLW = 512, INW = 5632, DFF = 4096, NHEAD = 8;
constexpr float NORM_EPS = 1e-6f, SUBLN_EPS = 1e-5f, LAMBDA_INIT = 0.2f;

typedef unsigned short bf16_t;
typedef short bf16x8 __attribute__((ext_vector_type(8)));
typedef short s16x4 __attribute__((ext_vector_type(4)));
typedef float f32x4 __attribute__((ext_vector_type(4)));
typedef float f32x2 __attribute__((ext_vector_type(2)));
typedef float f32x16 __attribute__((ext_vector_type(16)));
typedef unsigned u32x4 __attribute__((ext_vector_type(4)));
typedef unsigned u32x2 __attribute__((ext_vector_type(2)));
#define LAS __attribute__((address_space(3)))

typedef __bf16 bf16x2_t __attribute__((ext_vector_type(2)));
__device__ __forceinline__ unsigned cvt_pk_bf16(float lo, float hi) { f32x2 v = {lo, hi}; bf16x2_t b = __builtin_convertvector(v, bf16x2_t); return __builtin_bit_cast(unsigned, b); }
__device__ __forceinline__ float bf_lo(unsigned w) { return __uint_as_float(w << 16); }
__device__ __forceinline__ float bf_hi(unsigned w) { return __uint_as_float(w & 0xffff0000u); }
__device__ __forceinline__ float wave_sum(float v) {
#pragma unroll
    for (int o = 1; o < 64; o <<= 1) v += __shfl_xor(v, o);
    return v;
}
__device__ __forceinline__ float fast_sigmoid(float x) { return __builtin_amdgcn_rcpf(1.0f + __builtin_amdgcn_exp2f(-1.4426950408889634f * x)); }

constexpr size_t MiB = 1u << 20;
constexpr size_t WS_ROPE = 1 * MiB, WS_RS1 = 2 * MiB, WS_RS2 = 6 * MiB;
constexpr size_t WS_WIN = 10 * MiB, WS_WATT = 22 * MiB, WS_WO = 24 * MiB, WS_WUP = 26 * MiB, WS_WDN = 34 * MiB, WS_WCOMB = 42 * MiB;
constexpr size_t WS_H = 64 * MiB, WS_MP = WS_H;
constexpr size_t WS_Q = 192 * MiB, WS_ATT = WS_Q;
constexpr size_t WS_K = 320 * MiB, WS_MG = WS_K;
constexpr size_t WS_V = 448 * MiB;
constexpr size_t WS_G = 576 * MiB, WS_XG = WS_G;
constexpr size_t WS_U = 832 * MiB, WS_P = 896 * MiB;
constexpr size_t WS_HB = 64 * MiB;
constexpr size_t WS_END = 960 * MiB;
constexpr int LDS_BYTES = 147456;

namespace pg8 {
constexpr int BM = 256, BK = 64, HALF = 128, HTB = HALF * BK * 2, STAGE_BYTES = 8 * HTB, NXCD = 8, WGM = 8;
__host__ __device__ __forceinline__ int lds_byte(int r, int c) { const int st = (r >> 4) * 2 + (c >> 5), rr = r & 15, cc = c & 31, ob = rr * 64 + cc * 2; return st * 1024 + (ob ^ (((ob >> 9) & 1) << 5)); }
__host__ __device__ __forceinline__ void stage_rc(int b, int& R, int& C) { const int st = b / 1024, sb = b % 1024, swz = sb ^ (((sb >> 9) & 1) << 5); R = (st >> 1) * 16 + swz / 64; C = (st & 1) * 32 + (swz % 64) / 2; }
__host__ __device__ __forceinline__ int perm32(int rho) { const int n = rho >> 4, i = rho & 15; return 8 * (i >> 2) + 4 * n + (i & 3); }

struct Unit { int pm, pn; };
struct Gemm { const bf16_t* A; const bf16_t* Bt; int M, N, K; };

struct StaticOrder {
    int nM, nN, nwg, G, c;
    __host__ __device__ void init(int M, int N, int G_, int c_) { nM = M / BM; nN = N / BM; nwg = nM * nN; G = G_; c = c_; }
    __host__ __device__ bool next(int i, Unit& u) const {
        const long L = (long)i * G + c; if (L >= nwg) return false;
        int wgid = (int)L; { const int q = nwg / NXCD, r = nwg % NXCD, xcd = wgid % NXCD, off = wgid / NXCD; wgid = (xcd < r ? xcd * (q + 1) : r * (q + 1) + (xcd - r) * q) + off; }
        const int nig = WGM * nN, gid = wgid / nig, fm = gid * WGM, gsz = (nM - fm) < WGM ? (nM - fm) : WGM;
        u.pm = fm + ((wgid % nig) % gsz); u.pn = (wgid % nig) / gsz; return true;
    }
    __device__ __forceinline__ void a_ready(const Unit&) const {}
    __device__ __forceinline__ void done(const Unit&) const {}
};


struct EpiProj {
    static constexpr bool PERM = true, AFTER_DRAIN = false;
    bf16_t *U, *Q, *Kb, *V, *G; const float* bgate; const f32x2* rope;
    __device__ __forceinline__ void operator()(const f32x4 (&acc)[2][2][4][2], const Unit& u, int wr, int wc, int fr, int fq) const {
        const int cb = u.pn * BM, row0 = u.pm * BM + wr * 64 + fr, lc = wc * 32 + 8 * fq;
        if (cb >= 512 && cb < 2560) {
            bf16_t* dst = (cb < 1536) ? Q : Kb; const int dcol = ((cb < 1536) ? cb - 512 : cb - 1536) + lc;
            const bool rot = ((wc & 1) == 0);
#pragma unroll
            for (int ai = 0; ai < 2; ++ai)
#pragma unroll
                for (int m = 0; m < 4; ++m) {
                    const int row = row0 + ai * HALF + m * 16, pos = row & (SEQ - 1);
                    f32x4 cs[4];
                    if (rot) {
#pragma unroll
                        for (int j = 0; j < 4; ++j) cs[j] = *(const f32x4*)(rope + pos * 8 + 2 * j);
                    }
#pragma unroll
                    for (int bj = 0; bj < 2; ++bj) {
                        f32x4 v0 = acc[ai][bj][m][0], v1 = acc[ai][bj][m][1];
                        if (rot) {
                            float a[8] = {v0[0], v0[1], v0[2], v0[3], v1[0], v1[1], v1[2], v1[3]};
#pragma unroll
                            for (int j = 0; j < 8; ++j) {
                                const float p = __shfl_xor(a[j], 16);
                                const float c = cs[j >> 1][(j & 1) * 2], s = cs[j >> 1][(j & 1) * 2 + 1];
                                const float r0 = a[j] * c - p * s, r1 = a[j] * c + p * s;
                                a[j] = (fq == 0) ? r0 : ((fq == 1) ? r1 : a[j]);
                            }
                            v0 = (f32x4){a[0], a[1], a[2], a[3]}; v1 = (f32x4){a[4], a[5], a[6], a[7]};
                        }
                        u32x4 w; w.x = cvt_pk_bf16(v0[0], v0[1]); w.y = cvt_pk_bf16(v0[2], v0[3]); w.z = cvt_pk_bf16(v1[0], v1[1]); w.w = cvt_pk_bf16(v1[2], v1[3]);
                        if (cb < 1536) *(u32x4*)(dst + (size_t)row * DM + dcol + bj * HALF) = w;
                        else *(u32x4*)(dst + ((size_t)((row >> 13) * NHEAD + ((cb - 1536) >> 7) + bj) * SEQ + (row & (SEQ - 1))) * 128 + lc) = w;
                    }
                }
        } else if (cb >= 3584) {
            const int gcol = cb - 3584 + lc;
            f32x4 bv[2][2];
#pragma unroll
            for (int bj = 0; bj < 2; ++bj)
#pragma unroll
                for (int n = 0; n < 2; ++n) bv[bj][n] = *(const f32x4*)(bgate + gcol + bj * HALF + 4 * n);
#pragma unroll
            for (int ai = 0; ai < 2; ++ai)
#pragma unroll
                for (int m = 0; m < 4; ++m) {
                    const int row = row0 + ai * HALF + m * 16;
#pragma unroll
                    for (int bj = 0; bj < 2; ++bj) {
                        const f32x4 v0 = acc[ai][bj][m][0] + bv[bj][0], v1 = acc[ai][bj][m][1] + bv[bj][1];
                        u32x4 w; w.x = cvt_pk_bf16(fast_sigmoid(v0[0]), fast_sigmoid(v0[1])); w.y = cvt_pk_bf16(fast_sigmoid(v0[2]), fast_sigmoid(v0[3]));
                        w.z = cvt_pk_bf16(fast_sigmoid(v1[0]), fast_sigmoid(v1[1])); w.w = cvt_pk_bf16(fast_sigmoid(v1[2]), fast_sigmoid(v1[3]));
                        *(u32x4*)(G + (size_t)row * (2 * DM) + gcol + bj * HALF) = w;
                    }
                }
        } else if (cb >= 2560) {
#pragma unroll
            for (int ai = 0; ai < 2; ++ai)
#pragma unroll
                for (int m = 0; m < 4; ++m) {
                    const int row = row0 + ai * HALF + m * 16;
#pragma unroll
                    for (int bj = 0; bj < 2; ++bj) {
                        const f32x4 v0 = acc[ai][bj][m][0], v1 = acc[ai][bj][m][1];
                        u32x4 w; w.x = cvt_pk_bf16(v0[0], v0[1]); w.y = cvt_pk_bf16(v0[2], v0[3]); w.z = cvt_pk_bf16(v1[0], v1[1]); w.w = cvt_pk_bf16(v1[2], v1[3]);
                        *(u32x4*)(V + ((size_t)((row >> 13) * NHEAD + ((cb - 2560) >> 7) + bj) * SEQ + (row & (SEQ - 1))) * 128 + lc) = w;
                    }
                }
        } else {
            bf16_t* dst = U; const int ld = POOLW; const int dcol = cb + lc;
#pragma unroll
            for (int ai = 0; ai < 2; ++ai)
#pragma unroll
                for (int m = 0; m < 4; ++m) {
                    const int row = row0 + ai * HALF + m * 16;
#pragma unroll
                    for (int bj = 0; bj < 2; ++bj) {
                        const f32x4 v0 = acc[ai][bj][m][0], v1 = acc[ai][bj][m][1];
                        u32x4 w; w.x = cvt_pk_bf16(v0[0], v0[1]); w.y = cvt_pk_bf16(v0[2], v0[3]); w.z = cvt_pk_bf16(v1[0], v1[1]); w.w = cvt_pk_bf16(v1[2], v1[3]);
                        *(u32x4*)(dst + (size_t)row * ld + dcol + bj * HALF) = w;
                    }
                }
        }
    }
};

template <bool ADD> struct EpiGate {
    static constexpr bool PERM = true, AFTER_DRAIN = false;
    const bf16_t* G; int goff; const bf16_t* prev; bf16_t* O;
    __device__ __forceinline__ void operator()(const f32x4 (&acc)[2][2][4][2], const Unit& u, int wr, int wc, int fr, int fq) const {
        const int row0 = u.pm * BM + wr * 64 + fr, col0 = u.pn * BM + wc * 32 + 8 * fq;
#pragma unroll
        for (int ai = 0; ai < 2; ++ai) {
            u32x4 gq[4][2], pq[4][2];
#pragma unroll
            for (int m = 0; m < 4; ++m)
#pragma unroll
                for (int bj = 0; bj < 2; ++bj) { const int row = row0 + ai * HALF + m * 16;
                    gq[m][bj] = *(const u32x4*)(G + (size_t)row * (2 * DM) + goff + col0 + bj * HALF);
                    if (ADD) pq[m][bj] = *(const u32x4*)(prev + (size_t)row * DM + col0 + bj * HALF); }
#pragma unroll
            for (int m = 0; m < 4; ++m) {
                const int row = row0 + ai * HALF + m * 16;
#pragma unroll
                for (int bj = 0; bj < 2; ++bj) {
                    const u32x4 g = gq[m][bj];
                    f32x4 v0 = acc[ai][bj][m][0], v1 = acc[ai][bj][m][1];
                    v0 = v0 * (f32x4){bf_lo(g.x), bf_hi(g.x), bf_lo(g.y), bf_hi(g.y)};
                    v1 = v1 * (f32x4){bf_lo(g.z), bf_hi(g.z), bf_lo(g.w), bf_hi(g.w)};
                    if (ADD) {
                        const u32x4 p = pq[m][bj];
                        v0 = v0 + (f32x4){bf_lo(p.x), bf_hi(p.x), bf_lo(p.y), bf_hi(p.y)};
                        v1 = v1 + (f32x4){bf_lo(p.z), bf_hi(p.z), bf_lo(p.w), bf_hi(p.w)};
                    }
                    u32x4 w; w.x = cvt_pk_bf16(v0[0], v0[1]); w.y = cvt_pk_bf16(v0[2], v0[3]); w.z = cvt_pk_bf16(v1[0], v1[1]); w.w = cvt_pk_bf16(v1[2], v1[3]);
                    *(u32x4*)(O + (size_t)row * DM + col0 + bj * HALF) = w;
                }
            }
            asm volatile("" ::: "memory");
        }
    }
};

template <bool XG> struct EpiRes {
    static constexpr bool PERM = false, AFTER_DRAIN = false;
    const float* xi; float* xo; bf16_t* xg; const float* g; float* rowss;
    __device__ __forceinline__ void operator()(const f32x4 (&acc)[2][2][4][2], const Unit& u, int wr, int wc, int fr, int fq) const {
        const int col0 = u.pn * BM + wc * 32 + 4 * fq;
        f32x4 gv[2][2];
        if (XG) {
#pragma unroll
            for (int bj = 0; bj < 2; ++bj)
#pragma unroll
                for (int n = 0; n < 2; ++n) gv[bj][n] = *(const f32x4*)(g + col0 + bj * HALF + n * 16);
        }
#pragma unroll
        for (int ai = 0; ai < 2; ++ai) {
            f32x4 xv[4][2][2];
#pragma unroll
            for (int m = 0; m < 4; ++m) { const size_t off = (size_t)(u.pm * BM + ai * HALF + wr * 64 + m * 16 + fr) * DM + col0;
#pragma unroll
                for (int bj = 0; bj < 2; ++bj)
#pragma unroll
                    for (int n = 0; n < 2; ++n) xv[m][bj][n] = *(const f32x4*)(xi + off + bj * HALF + n * 16); }
#pragma unroll
            for (int m = 0; m < 4; ++m) {
                const int row = u.pm * BM + ai * HALF + wr * 64 + m * 16 + fr; const size_t off = (size_t)row * DM + col0;
                float ss = 0.f;
#pragma unroll
                for (int bj = 0; bj < 2; ++bj)
#pragma unroll
                    for (int n = 0; n < 2; ++n) {
                        const f32x4 v = acc[ai][bj][m][n] + xv[m][bj][n];
                        *(f32x4*)(xo + off + bj * HALF + n * 16) = v;
                        ss += (v[0] * v[0] + v[1] * v[1]) + (v[2] * v[2] + v[3] * v[3]);
                        if (XG) { const f32x4 w = v * gv[bj][n]; u32x2 p; p.x = cvt_pk_bf16(w[0], w[1]); p.y = cvt_pk_bf16(w[2], w[3]); *(u32x2*)(xg + off + bj * HALF + n * 16) = p; }
                    }
                ss += __shfl_xor(ss, 16); ss += __shfl_xor(ss, 32);
                if (fq == 0) rowss[(size_t)row * 16 + u.pn * 4 + wc] = ss;
            }
            asm volatile("" ::: "memory");
        }
    }
};

struct EpiUp {
    static constexpr bool PERM = true, AFTER_DRAIN = false;
    const float* rowss; bf16_t* O;
    __device__ __forceinline__ void operator()(const f32x4 (&acc)[2][2][4][2], const Unit& u, int wr, int wc, int fr, int fq) const {
        const int row0 = u.pm * BM + wr * 64 + fr, col0 = u.pn * BM + wc * 32 + 8 * fq;
#pragma unroll
        for (int ai = 0; ai < 2; ++ai)
#pragma unroll
            for (int m = 0; m < 4; ++m) {
                const int row = row0 + ai * HALF + m * 16;
                const f32x4 pz = *(const f32x4*)(rowss + (size_t)row * 16 + 4 * fq);
                float ss = (pz[0] + pz[1]) + (pz[2] + pz[3]); ss += __shfl_xor(ss, 16); ss += __shfl_xor(ss, 32);
                const float rstd = __builtin_amdgcn_rsqf(ss * (1.0f / DM) + NORM_EPS);
#pragma unroll
                for (int bj = 0; bj < 2; ++bj) {
                    f32x4 v0 = acc[ai][bj][m][0] * rstd, v1 = acc[ai][bj][m][1] * rstd;
#pragma unroll
                    for (int e = 0; e < 4; ++e) { const float a = fmaxf(v0[e], 0.f), b = fmaxf(v1[e], 0.f); v0[e] = a * a; v1[e] = b * b; }
                    u32x4 w; w.x = cvt_pk_bf16(v0[0], v0[1]); w.y = cvt_pk_bf16(v0[2], v0[3]); w.z = cvt_pk_bf16(v1[0], v1[1]); w.w = cvt_pk_bf16(v1[2], v1[3]);
                    *(u32x4*)(O + (size_t)row * DFF + col0 + bj * HALF) = w;
                }
            }
    }
};

template <class Epi, class Sched, bool ALIGN_EPI = false, bool SP2 = false>
__device__ __forceinline__ void gemm_phase(LAS unsigned char* lds, const Gemm g, const Sched& S, const Epi& E) {
    int tid_ = threadIdx.x; asm volatile("" : "+v"(tid_));
    const int tid = tid_, wid = __builtin_amdgcn_readfirstlane(tid >> 6), lane = tid & 63, wr = wid >> 2, wc = wid & 3, fr = lane & 15, fq = lane >> 4;
    const int K = g.K, nt = K / BK;
    unsigned voffA[2], voffB[2];
#pragma unroll
    for (int i = 0; i < 2; ++i) { int R, C; stage_rc(tid * 16 + i * 8192, R, C); const int Rb = Epi::PERM ? ((R & ~31) + perm32(R & 31)) : R;
        voffA[i] = (unsigned)(R * K + C) * 2u; voffB[i] = (unsigned)(Rb * K + C) * 2u; }
    const size_t kstep = (size_t)(BK * 2);
    const size_t hstep = (size_t)HALF * K * 2;
    const size_t tstep = 2 * hstep;
    const unsigned ldsw = (unsigned)wid * 1024u;
    const int aoff = lds_byte(wr * 64 + fr, fq * 8), boff = lds_byte(wc * 32 + fr, fq * 8);
#define PG8_SA(b, h) (((b) * 2 + (h)) * HTB)
#define PG8_SB(b, h) ((4 + (b) * 2 + (h)) * HTB)
#define PG8_STAGE(bufoff, gbase, voff) do { _Pragma("unroll") for (int _i = 0; _i < 2; ++_i) \
        __builtin_amdgcn_global_load_lds((const unsigned*)((const char*)(gbase) + (voff)[_i]), (LAS unsigned*)(lds + (bufoff) + ldsw + _i * 8192), 16, 0, 0); } while (0)
#define PG8_LDA(dst, b, h) do { _Pragma("unroll") for (int m = 0; m < 4; ++m) _Pragma("unroll") for (int k = 0; k < 2; ++k) dst[m][k] = *(const LAS bf16x8*)(lds + PG8_SA(b, h) + aoff + m * 2048 + k * 1024); } while (0)
#define PG8_LDB(dst, b, h) do { _Pragma("unroll") for (int n = 0; n < 2; ++n) _Pragma("unroll") for (int k = 0; k < 2; ++k) dst[n][k] = *(const LAS bf16x8*)(lds + PG8_SB(b, h) + boff + n * 2048 + k * 1024); } while (0)
#define PG8_MMA(ai, bj, At, Bt) do { __builtin_amdgcn_s_setprio(1); _Pragma("unroll") for (int m = 0; m < 4; ++m) _Pragma("unroll") for (int n = 0; n < 2; ++n) _Pragma("unroll") for (int k = 0; k < 2; ++k) \
        acc[ai][bj][m][n] = __builtin_amdgcn_mfma_f32_16x16x32_bf16(Bt[n][k], At[m][k], acc[ai][bj][m][n], 0, 0, 0); __builtin_amdgcn_s_setprio(0); } while (0)
#define PG8_WAIT_V(n) asm volatile("s_waitcnt vmcnt(" #n ")" ::: "memory")
#define PG8_WAIT_L(n) asm volatile("s_waitcnt lgkmcnt(" #n ")" ::: "memory")
#define PG8_BAR __builtin_amdgcn_s_barrier()
#define PG8_SCHED __builtin_amdgcn_sched_barrier(0)
    Unit cur, nxt; int ui = 0;
    if (!S.next(0, cur)) return;
    f32x4 acc[2][2][4][2];
#pragma unroll
    for (int a = 0; a < 2; ++a)
#pragma unroll
        for (int b = 0; b < 2; ++b)
#pragma unroll
            for (int m = 0; m < 4; ++m)
#pragma unroll
                for (int n = 0; n < 2; ++n) acc[a][b][m][n] = (f32x4){0.f, 0.f, 0.f, 0.f};
    bf16x8 At[4][2], B0[2][2], B1[2][2];
    const char* cA = (const char*)g.A + (size_t)cur.pm * tstep; const char* cB = (const char*)g.Bt + (size_t)cur.pn * tstep;
    S.a_ready(cur);
    if constexpr (SP2) {
        PG8_STAGE(PG8_SB(0, 0), cB, voffB); PG8_STAGE(PG8_SB(0, 1), cB + hstep, voffB); PG8_STAGE(PG8_SA(0, 0), cA, voffA); PG8_STAGE(PG8_SA(0, 1), cA + hstep, voffA);
        if (wr == 1) PG8_BAR;
        PG8_WAIT_V(2); PG8_BAR;
        PG8_STAGE(PG8_SB(1, 0), cB + kstep, voffB); PG8_STAGE(PG8_SA(1, 0), cA + kstep, voffA); PG8_STAGE(PG8_SB(1, 1), cB + hstep + kstep, voffB);
        PG8_WAIT_V(6); PG8_BAR;
    } else {
        PG8_STAGE(PG8_SB(0, 0), cB, voffB); PG8_STAGE(PG8_SA(0, 0), cA, voffA); PG8_STAGE(PG8_SB(0, 1), cB + hstep, voffB); PG8_STAGE(PG8_SA(0, 1), cA + hstep, voffA);
        if (wr == 1) PG8_BAR;
        PG8_WAIT_V(4); PG8_BAR;
        PG8_STAGE(PG8_SB(1, 0), cB + kstep, voffB); PG8_STAGE(PG8_SA(1, 0), cA + kstep, voffA); PG8_STAGE(PG8_SB(1, 1), cB + hstep + kstep, voffB);
        PG8_WAIT_V(6); PG8_BAR;
    }
    for (;;) {
        const bool has_next = S.next(ui + 1, nxt);
        const char* nA = has_next ? (const char*)g.A + (size_t)nxt.pm * tstep : cA; const char* nB = has_next ? (const char*)g.Bt + (size_t)nxt.pn * tstep : cB;
        for (int t = 0; t < nt; t += 2) {
            const bool last = (t == nt - 2);
            const char* a1 = cA + (size_t)(t + 1) * kstep;
            const char* a2 = last ? nA : cA + (size_t)(t + 2) * kstep; const char* b2 = last ? nB : cB + (size_t)(t + 2) * kstep;
            const char* a3 = a2 + kstep; const char* b3 = b2 + kstep;
            if (last && has_next) S.a_ready(nxt);
            if constexpr (SP2) {
            PG8_LDB(B0, 0, 0); PG8_LDB(B1, 0, 1); PG8_SCHED; PG8_LDA(At, 0, 0); PG8_STAGE(PG8_SA(1, 1), a1 + hstep, voffA);
            PG8_WAIT_V(8); PG8_WAIT_L(0); PG8_BAR; PG8_MMA(0, 0, At, B0); PG8_MMA(0, 1, At, B1); PG8_BAR; PG8_SCHED;
            PG8_LDA(At, 0, 1); PG8_STAGE(PG8_SB(0, 0), b2, voffB); PG8_STAGE(PG8_SB(0, 1), b2 + hstep, voffB); PG8_STAGE(PG8_SA(0, 0), a2, voffA);
            PG8_WAIT_V(8); PG8_WAIT_L(0); PG8_BAR; PG8_MMA(1, 0, At, B0); PG8_MMA(1, 1, At, B1); PG8_BAR; PG8_SCHED;
            PG8_LDB(B0, 1, 0); PG8_LDB(B1, 1, 1); PG8_SCHED; PG8_LDA(At, 1, 0); PG8_STAGE(PG8_SA(0, 1), a2 + hstep, voffA);
            PG8_WAIT_V(8); PG8_WAIT_L(0); PG8_BAR; PG8_MMA(0, 0, At, B0); PG8_MMA(0, 1, At, B1); PG8_BAR; PG8_SCHED;
            PG8_LDA(At, 1, 1); PG8_STAGE(PG8_SB(1, 0), b3, voffB); PG8_STAGE(PG8_SB(1, 1), b3 + hstep, voffB); PG8_STAGE(PG8_SA(1, 0), a3, voffA);
            PG8_WAIT_V(8); PG8_WAIT_L(0); PG8_BAR; PG8_MMA(1, 0, At, B0); PG8_MMA(1, 1, At, B1); PG8_BAR; PG8_SCHED;
            } else {
            PG8_LDB(B0, 0, 0); PG8_SCHED; PG8_LDA(At, 0, 0); PG8_STAGE(PG8_SA(1, 1), a1 + hstep, voffA);
            PG8_WAIT_L(8); PG8_BAR; PG8_WAIT_L(0); PG8_MMA(0, 0, At, B0); PG8_BAR; PG8_SCHED;
            PG8_LDB(B1, 0, 1); PG8_STAGE(PG8_SB(0, 0), b2, voffB);
            PG8_BAR; PG8_WAIT_L(0); PG8_MMA(0, 1, At, B1); PG8_BAR;
            PG8_LDA(At, 0, 1); PG8_STAGE(PG8_SA(0, 0), a2, voffA);
            PG8_BAR; PG8_WAIT_L(0); PG8_MMA(1, 0, At, B0); PG8_BAR; PG8_SCHED;
            PG8_STAGE(PG8_SB(0, 1), b2 + hstep, voffB);
            PG8_WAIT_V(6); PG8_BAR; PG8_MMA(1, 1, At, B1); PG8_BAR;
            PG8_LDB(B0, 1, 0); PG8_SCHED; PG8_LDA(At, 1, 0); PG8_STAGE(PG8_SA(0, 1), a2 + hstep, voffA);
            PG8_WAIT_L(8); PG8_BAR; PG8_WAIT_L(0); PG8_MMA(0, 0, At, B0); PG8_BAR; PG8_SCHED;
            PG8_LDB(B1, 1, 1); PG8_STAGE(PG8_SB(1, 0), b3, voffB);
            PG8_BAR; PG8_WAIT_L(0); PG8_MMA(0, 1, At, B1); PG8_BAR;
            PG8_LDA(At, 1, 1); PG8_STAGE(PG8_SA(1, 0), a3, voffA);
            PG8_BAR; PG8_WAIT_L(0); PG8_MMA(1, 0, At, B0); PG8_BAR; PG8_SCHED;
            PG8_STAGE(PG8_SB(1, 1), b3 + hstep, voffB);
            PG8_WAIT_V(6); PG8_BAR; PG8_MMA(1, 1, At, B1); PG8_BAR;
            }
        }
        if constexpr (ALIGN_EPI) { if (wr == 0) PG8_BAR; }
        if constexpr (!Epi::AFTER_DRAIN) { E(acc, cur, wr, wc, fr, fq); S.done(cur); }
        if (!has_next) break;
#pragma unroll
        for (int a = 0; a < 2; ++a)
#pragma unroll
            for (int b = 0; b < 2; ++b)
#pragma unroll
                for (int m = 0; m < 4; ++m)
#pragma unroll
                    for (int n = 0; n < 2; ++n) acc[a][b][m][n] = (f32x4){0.f, 0.f, 0.f, 0.f};
        cur = nxt; cA = nA; cB = nB; ++ui;
        if constexpr (ALIGN_EPI) { if (wr == 1) PG8_BAR; }
    }
    PG8_WAIT_V(0);
    if constexpr (!ALIGN_EPI) { if (wr == 0) PG8_BAR; }
    PG8_BAR;
#undef PG8_SA
#undef PG8_SB
#undef PG8_STAGE
#undef PG8_LDA
#undef PG8_LDB
#undef PG8_MMA
#undef PG8_WAIT_V
#undef PG8_WAIT_L
#undef PG8_BAR
#undef PG8_SCHED
}
}

namespace att {
constexpr int LD = DM, LDK = 128, KVBLK = 64, UROWS = 128;
constexpr float SCALE = 0.125f, THR = 8.f;
constexpr int SHM_V = 16384, SHM_K = 16384;
constexpr int OFF_V = 0, OFF_K = 2 * SHM_V, OFF_WS = OFF_K + 2 * SHM_K, OFF_OST = OFF_WS + 8 * 64 * 4, ATT_LDS = OFF_OST + 4 * 32 * 128 * 4;
static_assert(ATT_LDS <= LDS_BYTES, "attention LDS");
#define KSWZ(row, colB) ((row) * 256 + ((colB) ^ (((row) & 7) << 4)))
#define SBAR() __builtin_amdgcn_sched_barrier(0)
__device__ __forceinline__ int crow(int r, int hi) { return (r & 3) + 8 * (r >> 2) + 4 * hi; }

__device__ __forceinline__ void partialSM(f32x16& p0, f32x16& p1, float& m_reg, float& mn, float& alpha) {
  constexpr float C = SCALE * 1.4426950408889634f;
  float pmax = p0[0];
#pragma unroll
  for (int r = 1; r < 16; ++r) pmax = fmaxf(pmax, p0[r]);
#pragma unroll
  for (int r = 0; r < 16; ++r) pmax = fmaxf(pmax, p1[r]);
  { auto rr = __builtin_amdgcn_permlane32_swap(__float_as_uint(pmax), __float_as_uint(pmax), false, false);
    pmax = fmaxf(__uint_as_float(rr[0]), __uint_as_float(rr[1])); }
  if (__builtin_expect(__all(pmax - m_reg <= THR / SCALE), 1)) { mn = m_reg; alpha = 1.f; }
  else { mn = fmaxf(m_reg, pmax); alpha = __builtin_amdgcn_exp2f((m_reg - mn) * C); m_reg = mn; }
  float mnC = -mn * C;
#pragma unroll
  for (int r = 0; r < 16; ++r) p0[r] = fmaf(p0[r], C, mnC);
#pragma unroll
  for (int r = 0; r < 16; ++r) p1[r] = fmaf(p1[r], C, mnC);
#pragma unroll
  for (int r = 0; r < 16; ++r) p0[r] = __builtin_amdgcn_exp2f(p0[r]);
}
__device__ __forceinline__ void finishSM(f32x16& p0, f32x16& p1, float alpha, float& l_reg, bf16x8& pa0, bf16x8& pa1, bf16x8& pa2, bf16x8& pa3) {
#pragma unroll
  for (int r = 0; r < 16; ++r) p1[r] = __builtin_amdgcn_exp2f(p1[r]);
  float ps = 0;
#pragma unroll
  for (int r = 0; r < 16; ++r) ps += p0[r];
#pragma unroll
  for (int r = 0; r < 16; ++r) ps += p1[r];
  { auto rr = __builtin_amdgcn_permlane32_swap(__float_as_uint(ps), __float_as_uint(ps), false, false);
    ps = __uint_as_float(rr[0]) + __uint_as_float(rr[1]); }
  l_reg = l_reg * alpha + ps;
#define PK4(P, BASE, OUT) do { unsigned a0 = cvt_pk_bf16(P[BASE + 0], P[BASE + 1]), a1 = cvt_pk_bf16(P[BASE + 2], P[BASE + 3]);   \
    unsigned b0 = cvt_pk_bf16(P[BASE + 4], P[BASE + 5]), b1 = cvt_pk_bf16(P[BASE + 6], P[BASE + 7]);                              \
    auto r0 = __builtin_amdgcn_permlane32_swap(a0, b0, false, false); auto r1 = __builtin_amdgcn_permlane32_swap(a1, b1, false, false); \
    u32x4 w = {r0[0], r1[0], r0[1], r1[1]}; OUT = *reinterpret_cast<bf16x8*>(&w); } while (0)
  PK4(p0, 0, pa0); PK4(p0, 8, pa1); PK4(p1, 0, pa2); PK4(p1, 8, pa3);
#undef PK4
}
__device__ __forceinline__ void qkt(f32x16& p0, f32x16& p1, const char* Ks, const bf16x8* qr, int r32, int kcb) {
  p0 = f32x16{}; p1 = f32x16{};
#pragma unroll
  for (int d0 = 0; d0 < 4; ++d0) { const int cb = kcb + d0 * 32;
    bf16x8 b0 = *reinterpret_cast<const bf16x8*>(Ks + KSWZ(r32, cb));
    bf16x8 b1 = *reinterpret_cast<const bf16x8*>(Ks + KSWZ(32 + r32, cb));
    p0 = __builtin_amdgcn_mfma_f32_32x32x16_bf16(b0, qr[d0], p0, 0, 0, 0);
    p1 = __builtin_amdgcn_mfma_f32_32x32x16_bf16(b1, qr[d0], p1, 0, 0, 0); }
}
__device__ __forceinline__ int v_st(int k, int c) { const int kk = (k & ~0xC) | ((k & 4) << 1) | ((k & 8) >> 1); return ((kk >> 3) * 4 + (c >> 5)) * 512 + ((kk & 7) * 32 + (c & 31)) * 2; }
__device__ __forceinline__ int v_rd_base(int lane) { return ((lane & 3) << 3) | (((lane >> 2) & 3) << 6) | (((lane >> 4) & 1) << 5) | (((lane >> 5) & 1) << 8); }
constexpr int v_rd_off(int d0, int ks, int half) { return d0 * 512 + ks * 4096 + half * 2048; }
typedef short v4i16_t __attribute__((ext_vector_type(4)));
typedef LAS const char* lds_cptr;
__device__ __forceinline__ s16x4 vtr(lds_cptr p) { return __builtin_bit_cast(s16x4, __builtin_amdgcn_ds_read_tr16_b64_v4i16((LAS v4i16_t*)p)); }
#define PVRD(L, H, D0) do { _Pragma("unroll") for (int ks = 0; ks < 4; ++ks) { L[ks] = vtr(vp + v_rd_off(D0, ks, 0)); H[ks] = vtr(vp + v_rd_off(D0, ks, 1)); } } while (0)
#define PVPK(L, H) (bf16x8){L[0], L[1], L[2], L[3], H[0], H[1], H[2], H[3]}
#define PVMM(L, H, D0) do { o[D0] = __builtin_amdgcn_mfma_f32_32x32x16_bf16(pa0, PVPK(L[0], H[0]), o[D0], 0, 0, 0); o[D0] = __builtin_amdgcn_mfma_f32_32x32x16_bf16(pa1, PVPK(L[1], H[1]), o[D0], 0, 0, 0); \
    o[D0] = __builtin_amdgcn_mfma_f32_32x32x16_bf16(pa2, PVPK(L[2], H[2]), o[D0], 0, 0, 0); o[D0] = __builtin_amdgcn_mfma_f32_32x32x16_bf16(pa3, PVPK(L[3], H[3]), o[D0], 0, 0, 0); } while (0)
__device__ __forceinline__ void pv_d0(f32x16* o, lds_cptr vp, bf16x8 pa0, bf16x8 pa1, bf16x8 pa2, bf16x8 pa3) {
  s16x4 la[4], ha[4], lb[4], hb[4];
  PVRD(la, ha, 0); SBAR();
  PVRD(lb, hb, 1); PVMM(la, ha, 0); SBAR();
  PVRD(la, ha, 2); PVMM(lb, hb, 1); SBAR();
  PVRD(lb, hb, 3); PVMM(la, ha, 2); SBAR();
  PVMM(lb, hb, 3);
}
#undef PVRD
#undef PVPK
#undef PVMM

__device__ __forceinline__ void attn_unit(const bf16_t* Qb, const bf16_t* __restrict__ Kh, const bf16_t* __restrict__ Vh, bf16_t* Ob, int seq, float lam, const float* __restrict__ gsub, char* lds) {
  int tid_ = threadIdx.x; asm volatile("" : "+v"(tid_));
  const int tid = tid_, lane = tid & 63, r32 = lane & 31, hi = lane >> 5;
  const int wid = __builtin_amdgcn_readfirstlane(tid >> 6), mc = wid >> 2, wq = wid & 3;
  char* V_lds = lds + OFF_V; char* K_lds = lds + OFF_K;
  float* ws = (float*)(lds + OFF_WS) + wid * 64; float* li_l = ws; float* al_l = ws + 32;
  float m_reg = -1e30f, l_reg = 0; f32x16 o[4] = {}; bf16x8 qr[4];
  const bf16_t* Qw = Qb + (long)(wq * 32 + r32) * LD + mc * 64 + hi * 8;
#pragma unroll
  for (int d0 = 0; d0 < 4; ++d0) qr[d0] = *reinterpret_cast<const bf16x8*>(Qw + d0 * 16);
  const int kcb = mc * 128 + hi * 16;
  const int sr = tid >> 4, sc = (tid & 15) * 8, vst0 = v_st(sr, sc), vst1 = v_st(32 + sr, sc);
  const lds_cptr vb0 = (lds_cptr)V_lds + v_rd_base(lane);
  struct { bf16x8 vs0, vs1, ks0, ks1; } sr_[2];
#define SLOAD(i, k0) do { sr_[i].vs0 = *reinterpret_cast<const bf16x8*>(&Vh[(long)((k0) + sr) * LDK + sc]); sr_[i].vs1 = *reinterpret_cast<const bf16x8*>(&Vh[(long)((k0) + 32 + sr) * LDK + sc]); \
    sr_[i].ks0 = *reinterpret_cast<const bf16x8*>(&Kh[(long)((k0) + sr) * LDK + sc]); sr_[i].ks1 = *reinterpret_cast<const bf16x8*>(&Kh[(long)((k0) + 32 + sr) * LDK + sc]); } while (0)
#define SWRITE(b, i) do { *(bf16x8*)(V_lds + (b) * SHM_V + vst0) = sr_[i].vs0;          \
    *(bf16x8*)(V_lds + (b) * SHM_V + vst1) = sr_[i].vs1; int kc = sc * 2;               \
    *(bf16x8*)(K_lds + (b) * SHM_K + KSWZ(sr, kc)) = sr_[i].ks0;                       \
    *(bf16x8*)(K_lds + (b) * SHM_K + KSWZ(32 + sr, kc)) = sr_[i].ks1; } while (0)
#define SWAIT() asm volatile("s_waitcnt vmcnt(4)" ::: "memory")
#define RESC(a) do { if (__any((a) < 1.f)) { if (hi == 0) al_l[r32] = (a); asm volatile("s_waitcnt lgkmcnt(0)" ::: "memory"); \
    _Pragma("unroll") for (int d = 0; d < 4; ++d) _Pragma("unroll") for (int r = 0; r < 16; ++r) o[d][r] *= al_l[crow(r, hi)]; } } while (0)
  f32x16 pA0, pA1, pB0, pB1; float mnA, mnB, alA, alB; bf16x8 pa0, pa1, pa2, pa3; const int NT = seq / KVBLK;
  constexpr int SE = 0, SO = 1;
  SLOAD(SE, 0); asm volatile("s_waitcnt vmcnt(0)" ::: "memory"); SWRITE(0, SE); __syncthreads();
  qkt(pA0, pA1, K_lds, qr, r32, kcb); partialSM(pA0, pA1, m_reg, mnA, alA);
  SLOAD(SO, KVBLK); SLOAD(SE, (2 < NT ? 2 : NT - 1) * KVBLK);
  SWAIT(); SWRITE(1, SO); __syncthreads();
  for (int j = 1; j + 1 < NT; j += 2) {
    SBAR(); qkt(pB0, pB1, K_lds + SHM_K, qr, r32, kcb);
    finishSM(pA0, pA1, alA, l_reg, pa0, pa1, pa2, pa3); SBAR();
    SLOAD(SO, (j + 2) * KVBLK); SBAR();
    pv_d0(o, vb0, pa0, pa1, pa2, pa3); partialSM(pB0, pB1, m_reg, mnB, alB);
    __syncthreads(); SWAIT(); SWRITE(0, SE);
    RESC(alB); __syncthreads();
    SBAR(); qkt(pA0, pA1, K_lds, qr, r32, kcb);
    finishSM(pB0, pB1, alB, l_reg, pa0, pa1, pa2, pa3); SBAR();
    SLOAD(SE, (j + 3 < NT ? j + 3 : NT - 1) * KVBLK); SBAR();
    pv_d0(o, vb0 + SHM_V, pa0, pa1, pa2, pa3); partialSM(pA0, pA1, m_reg, mnA, alA);
    __syncthreads(); SWAIT(); SWRITE(1, SO);
    RESC(alA); __syncthreads();
  }
  SBAR(); qkt(pB0, pB1, K_lds + SHM_K, qr, r32, kcb);
  if (wq < 2) {
#pragma unroll
    for (int r = 0; r < 16; ++r) { pB0[r] = -1e30f; pB1[r] = -1e30f; }
  }
  finishSM(pA0, pA1, alA, l_reg, pa0, pa1, pa2, pa3); SBAR();
  pv_d0(o, vb0, pa0, pa1, pa2, pa3); partialSM(pB0, pB1, m_reg, mnB, alB);
  __syncthreads(); RESC(alB);
  finishSM(pB0, pB1, alB, l_reg, pa0, pa1, pa2, pa3); SBAR();
  pv_d0(o, vb0 + SHM_V, pa0, pa1, pa2, pa3);
  if (hi == 0) li_l[r32] = l_reg; asm volatile("s_waitcnt lgkmcnt(0)" ::: "memory");
  float rli[16];
#pragma unroll
  for (int r = 0; r < 16; ++r) rli[r] = __builtin_amdgcn_rcpf(li_l[crow(r, hi)]);
  float* ost = (float*)(lds + OFF_OST) + wq * (32 * 128);
  if (mc == 1) {
#pragma unroll
    for (int r = 0; r < 16; ++r)
#pragma unroll
      for (int d0 = 0; d0 < 4; ++d0) ost[crow(r, hi) * 128 + d0 * 32 + r32] = o[d0][r] * (rli[r] * lam);
  }
  __syncthreads();
  if (mc == 0) {
#pragma unroll
    for (int r = 0; r < 16; ++r)
#pragma unroll
      for (int d0 = 0; d0 < 4; ++d0) { const int ix = crow(r, hi) * 128 + d0 * 32 + r32; ost[ix] = o[d0][r] * rli[r] - ost[ix]; }
  }
  __syncthreads();
  { int tid2 = threadIdx.x; asm volatile("" : "+v"(tid2));
    const int row = tid2 >> 2, qt = tid2 & 3;
    const float* src = (const float*)(lds + OFF_OST) + row * 128 + qt * 32;
    f32x4 v[8]; float ss = 0.f;
#pragma unroll
    for (int i = 0; i < 8; ++i) { v[i] = *(const f32x4*)(src + 4 * i); ss += (v[i][0] * v[i][0] + v[i][1] * v[i][1]) + (v[i][2] * v[i][2] + v[i][3] * v[i][3]); }
    ss += __shfl_xor(ss, 1); ss += __shfl_xor(ss, 2);
    const float rs = __builtin_amdgcn_rsqf(ss * (1.0f / 128.0f) + SUBLN_EPS) * (1.0f - LAMBDA_INIT);
    bf16_t* dst = Ob + (long)row * LD + qt * 32;
#pragma unroll
    for (int i = 0; i < 4; ++i) {
      const f32x4 g0 = *(const f32x4*)(gsub + qt * 32 + 8 * i), g1 = *(const f32x4*)(gsub + qt * 32 + 8 * i + 4);
      const f32x4 a = v[2 * i] * g0 * rs, b = v[2 * i + 1] * g1 * rs;
      u32x4 w; w.x = cvt_pk_bf16(a[0], a[1]); w.y = cvt_pk_bf16(a[2], a[3]); w.z = cvt_pk_bf16(b[0], b[1]); w.w = cvt_pk_bf16(b[2], b[3]);
      *(u32x4*)(dst + 8 * i) = w;
    }
  }
  __syncthreads();
#undef SLOAD
#undef SWRITE
#undef SWAIT
#undef RESC
}
#undef SBAR
}

__device__ __forceinline__ unsigned f2bf(float f) { unsigned u = __builtin_bit_cast(unsigned, f); return (u + 0x7fffu + ((u >> 16) & 1u)) >> 16; }
__device__ __forceinline__ unsigned pk2(float lo, float hi) { return f2bf(lo) | (f2bf(hi) << 16); }
__device__ __forceinline__ void transpose_item(const float* __restrict__ W, int K, int N, bf16_t* WT, LAS float* scr, int item, int lane) {
    const int nblk = N / 32, kb = item / nblk, nb = item % nblk, k0 = 64 * kb, n0 = 32 * nb;
#pragma unroll 8
    for (int i = 0; i < 32; ++i) { const int kk = 2 * i + (lane >> 5); scr[kk * 33 + (lane & 31)] = W[(size_t)(k0 + kk) * N + n0 + (lane & 31)]; }
    asm volatile("s_waitcnt lgkmcnt(0)" ::: "memory");
    const int c = lane & 7;
#pragma unroll
    for (int j = 0; j < 4; ++j) { const int n = (lane >> 3) + 8 * j; const LAS float* s = scr + (8 * c) * 33 + n;
        u32x4 o; o.x = pk2(s[0 * 33], s[1 * 33]); o.y = pk2(s[2 * 33], s[3 * 33]); o.z = pk2(s[4 * 33], s[5 * 33]); o.w = pk2(s[6 * 33], s[7 * 33]);
        *(u32x4*)(WT + (size_t)(n0 + n) * K + k0 + 8 * c) = o; }
    asm volatile("s_waitcnt lgkmcnt(0)" ::: "memory");
}

struct Args { const float* in[18]; float* out; unsigned char* ws; };
#define GRID_SYNC() do { asm volatile("s_waitcnt vmcnt(0) lgkmcnt(0)" ::: "memory"); grid.sync(); } while (0)

__global__ void __launch_bounds__(512) fwd_megakernel(Args a) {
    extern __shared__ __attribute__((aligned(16))) unsigned char lds[];
    cg::grid_group grid = cg::this_grid();
    const int tid = threadIdx.x, lane = tid & 63, wave = __builtin_amdgcn_readfirstlane(tid >> 6);
    const int G = gridDim.x, bx = blockIdx.x;
    const int gw = bx * 8 + wave, NGW = G * 8;
    const int gt = bx * 512 + tid, NGT = G * 512;
    unsigned char* ws = a.ws;
    const float* x = a.in[0]; const float* w_in = a.in[1]; const float* b_gate = a.in[2]; const float* pool_w = a.in[3]; const float* pool_scale = a.in[4];
    const float* lq1 = a.in[5]; const float* lk1 = a.in[6]; const float* lq2 = a.in[7]; const float* lk2 = a.in[8]; const float* g_subln = a.in[9];
    const float* w_pool_out = a.in[10]; const float* w_attn_out = a.in[11]; const float* w_o = a.in[12]; const float* g_mix = a.in[13]; const float* g_mlp = a.in[14];
    const float* w_up = a.in[15]; const float* w_down = a.in[16]; const float* g_final = a.in[17];
    float* out = a.out;
    f32x2* ROPE = (f32x2*)(ws + WS_ROPE); float* RS1 = (float*)(ws + WS_RS1); float* RS2 = (float*)(ws + WS_RS2);
    bf16_t* WIN = (bf16_t*)(ws + WS_WIN); bf16_t* WATT = (bf16_t*)(ws + WS_WATT); bf16_t* WO = (bf16_t*)(ws + WS_WO); bf16_t* WUP = (bf16_t*)(ws + WS_WUP);
    bf16_t* WDN = (bf16_t*)(ws + WS_WDN); bf16_t* WCOMB = (bf16_t*)(ws + WS_WCOMB);
    bf16_t* H = (bf16_t*)(ws + WS_H); bf16_t* MP = (bf16_t*)(ws + WS_MP); bf16_t* QB = (bf16_t*)(ws + WS_Q); bf16_t* ATT = (bf16_t*)(ws + WS_ATT);
    bf16_t* KB = (bf16_t*)(ws + WS_K); bf16_t* MG = (bf16_t*)(ws + WS_MG); bf16_t* VB = (bf16_t*)(ws + WS_V); bf16_t* GT = (bf16_t*)(ws + WS_G); bf16_t* XG = (bf16_t*)(ws + WS_XG);
    bf16_t* UB = (bf16_t*)(ws + WS_U); bf16_t* PB = (bf16_t*)(ws + WS_P); bf16_t* HB = (bf16_t*)(ws + WS_HB);
    LAS unsigned char* ldsl = (LAS unsigned char*)lds;

    {
        LAS float* scr = (LAS float*)(ldsl + wave * 16384);
        constexpr int I_IN = (DM / 64) * (INW / 32), I_AT = (DM / 64) * (DM / 32), I_O = I_AT, I_UP = (DM / 64) * (DFF / 32), I_DN = (DFF / 64) * (DM / 32);
        constexpr int NITEMS = I_IN + I_AT + I_O + I_UP + I_DN;
        for (int it = gw; it < NITEMS; it += NGW) {
            int r = it;
            if (r < I_IN) { transpose_item(w_in, DM, INW, WIN, scr, r, lane); continue; } r -= I_IN;
            if (r < I_AT) { transpose_item(w_attn_out, DM, DM, WATT, scr, r, lane); continue; } r -= I_AT;
            if (r < I_O) { transpose_item(w_o, DM, DM, WO, scr, r, lane); continue; } r -= I_O;
            if (r < I_UP) { transpose_item(w_up, DM, DFF, WUP, scr, r, lane); continue; } r -= I_UP;
            transpose_item(w_down, DFF, DM, WDN, scr, r, lane);
        }
        for (int wi = gw; wi < 1024; wi += NGW) {
            const int kk8 = wi >> 4, n = (wi & 15) * 64 + lane, g = kk8 >> 4, p0 = (kk8 & 15) * 8;
            float acc[8] = {0.f, 0.f, 0.f, 0.f, 0.f, 0.f, 0.f, 0.f};
            for (int q = 0; q < 128; ++q) {
                const int gq = g * 128 + q; const float wv = w_pool_out[(size_t)gq * DM + n] * pool_scale[gq];
#pragma unroll
                for (int j = 0; j < 8; ++j) acc[j] += pool_w[(size_t)(g * 128 + p0 + j) * 128 + q] * wv;
            }
            u32x4 o; o.x = pk2(acc[0], acc[1]); o.y = pk2(acc[2], acc[3]); o.z = pk2(acc[4], acc[5]); o.w = pk2(acc[6], acc[7]);
            *(u32x4*)(WCOMB + (size_t)n * POOLW + kk8 * 8) = o;
        }
        for (int e = gt; e < SEQ * 8; e += NGT) {
            const int pos = e >> 3, i = e & 7;
            const float inv = (i == 0) ? 1.0f : (i == 1) ? 0.1939227432012558f : (i == 2) ? 0.03760603070259094f : (i == 3) ? 0.007292664609849453f :
                              (i == 4) ? 0.0014142135623842478f : (i == 5) ? 0.00027424818836152554f : (i == 6) ? 5.3182957344688475e-05f : 1.0313385246263351e-05f;
            const float ang = (float)pos * inv;
            double rev = (double)ang * 0.15915494309189535; rev -= __builtin_rint(rev);
            const float rv = (float)rev;
            ROPE[e] = (f32x2){__builtin_amdgcn_cosf(rv), __builtin_amdgcn_sinf(rv)};
        }
        for (int m = gw; m < MTOK; m += NGW) {
            const f32x4* xr = (const f32x4*)(x + (size_t)m * DM) + lane;
            f32x4 v[4]; float s = 0.f;
#pragma unroll
            for (int j = 0; j < 4; ++j) { v[j] = xr[64 * j]; s += (v[j][0] * v[j][0] + v[j][1] * v[j][1]) + (v[j][2] * v[j][2] + v[j][3] * v[j][3]); }
            const float rstd = __builtin_amdgcn_rsqf(wave_sum(s) * (1.f / DM) + NORM_EPS);
            u32x2* o8 = (u32x2*)(H + (size_t)m * DM) + lane;
#pragma unroll
            for (int j = 0; j < 4; ++j) { const f32x4 gg = ((const f32x4*)g_mix)[lane + 64 * j]; const f32x4 w = v[j] * gg * rstd;
                u32x2 p; p.x = cvt_pk_bf16(w[0], w[1]); p.y = cvt_pk_bf16(w[2], w[3]); o8[64 * j] = p; }
        }
    }
    GRID_SYNC();

    {
        pg8::Gemm g{H, WIN, MTOK, INW, DM}; pg8::StaticOrder S; S.init(MTOK, INW, G, bx);
        pg8::EpiProj E{UB, QB, KB, VB, GT, b_gate, ROPE};
        pg8::gemm_phase<pg8::EpiProj, pg8::StaticOrder, true, true>(ldsl, g, S, E);
#if PROBE_DUP == 1
        __syncthreads(); pg8::gemm_phase<pg8::EpiProj, pg8::StaticOrder, true, true>(ldsl, g, S, E);
#endif
    }
    GRID_SYNC();

    {
        for (int it = gt; it < MTOK * 64; it += NGT) {
            const int m = it >> 6, col = (it & 63) * 8, gi = col >> 7, w = 2 << gi, t = m & (SEQ - 1);
            const int n = (t + 1 < w) ? t + 1 : w;
            float acc[8] = {0.f, 0.f, 0.f, 0.f, 0.f, 0.f, 0.f, 0.f};
            const bf16_t* up = UB + (size_t)m * POOLW + col;
            const u32x4 cur = *(const u32x4*)up;
            for (int j = 0; j < n; ++j) {
                const u32x4 v = *(const u32x4*)(up - (size_t)j * POOLW);
                acc[0] += bf_lo(v.x); acc[1] += bf_hi(v.x); acc[2] += bf_lo(v.y); acc[3] += bf_hi(v.y);
                acc[4] += bf_lo(v.z); acc[5] += bf_hi(v.z); acc[6] += bf_lo(v.w); acc[7] += bf_hi(v.w);
            }
            const float rn = 1.0f / (float)n;
            u32x4 o;
            o.x = cvt_pk_bf16(acc[0] * rn - bf_lo(cur.x), acc[1] * rn - bf_hi(cur.x)); o.y = cvt_pk_bf16(acc[2] * rn - bf_lo(cur.y), acc[3] * rn - bf_hi(cur.y));
            o.z = cvt_pk_bf16(acc[4] * rn - bf_lo(cur.z), acc[5] * rn - bf_hi(cur.z)); o.w = cvt_pk_bf16(acc[6] * rn - bf_lo(cur.w), acc[7] * rn - bf_hi(cur.w));
            *(u32x4*)(PB + (size_t)m * POOLW + col) = o;
        }
        int ln2 = threadIdx.x & 63; asm volatile("" : "+v"(ln2));
        const float s1 = wave_sum(lq1[ln2] * lk1[ln2]), s2 = wave_sum(lq2[ln2] * lk2[ln2]);
        const float lam = __expf(s1) - __expf(s2) + LAMBDA_INIT;
        for (int p = bx; p < 64 * 32; p += G) {
            const int bh = (p >> 8) * 8 + (p & 7), pr = (p & 255) >> 3, b = bh >> 3, h = bh & 7;
            const bf16_t* Kh = KB + (size_t)bh * SEQ * 128; const bf16_t* Vh = VB + (size_t)bh * SEQ * 128;
#pragma unroll 1
            for (int uu = 0; uu < 2; ++uu) {
                const int qb = uu ? pr : 63 - pr, q0 = qb * 128;
                const size_t qoff = ((size_t)b * SEQ + q0) * DM + h * 128;
#if PROBE_DUP == 2
                att::attn_unit(QB + qoff, Kh, Vh, H + qoff, q0 + 128, lam, g_subln, (char*)lds);
#endif
                att::attn_unit(QB + qoff, Kh, Vh, ATT + qoff, q0 + 128, lam, g_subln, (char*)lds);
            }
        }
    }
    GRID_SYNC();

    {
        pg8::StaticOrder S; S.init(MTOK, DM, G, bx);
        { pg8::Gemm g{PB, WCOMB, MTOK, DM, POOLW}; pg8::EpiGate<false> E{GT, 0, nullptr, MP};
          pg8::gemm_phase<pg8::EpiGate<false>, pg8::StaticOrder, true, true>(ldsl, g, S, E); }
        __threadfence(); __syncthreads();
        { pg8::Gemm g{ATT, WATT, MTOK, DM, DM}; pg8::EpiGate<true> E{GT, DM, MP, MG};
          pg8::gemm_phase<pg8::EpiGate<true>, pg8::StaticOrder, true, true>(ldsl, g, S, E); }
    }
    GRID_SYNC();

    {
        pg8::Gemm g{MG, WO, MTOK, DM, DM}; pg8::StaticOrder S; S.init(MTOK, DM, G, bx);
        pg8::EpiRes<true> E{x, out, XG, g_mlp, RS1};
        pg8::gemm_phase<pg8::EpiRes<true>, pg8::StaticOrder, true, true>(ldsl, g, S, E);
    }
    GRID_SYNC();

    {
        pg8::Gemm g{XG, WUP, MTOK, DFF, DM}; pg8::StaticOrder S; S.init(MTOK, DFF, G, bx);
        pg8::EpiUp E{RS1, HB};
        pg8::gemm_phase<pg8::EpiUp, pg8::StaticOrder, true, true>(ldsl, g, S, E);
#if PROBE_DUP == 5
        __syncthreads(); pg8::gemm_phase<pg8::EpiUp, pg8::StaticOrder, true, true>(ldsl, g, S, E);
#endif
    }
    GRID_SYNC();

    {
        pg8::Gemm g{HB, WDN, MTOK, DM, DFF}; pg8::StaticOrder S; S.init(MTOK, DM, G, bx);
        pg8::EpiRes<false> E{out, out, nullptr, nullptr, RS2};
        pg8::gemm_phase<pg8::EpiRes<false>, pg8::StaticOrder, true, true>(ldsl, g, S, E);
    }
    GRID_SYNC();

    int ln7 = threadIdx.x & 63; asm volatile("" : "+v"(ln7));
    for (int m = gw; m < MTOK; m += NGW) {
        float ps = (ln7 < 16) ? RS2[(size_t)m * 16 + ln7] : 0.f;
        ps = wave_sum(ps);
        const float rstd = __builtin_amdgcn_rsqf(ps * (1.f / DM) + NORM_EPS);
        f32x4* xr = (f32x4*)(out + (size_t)m * DM) + ln7;
#pragma unroll
        for (int j = 0; j < 4; ++j) { const f32x4 gg = ((const f32x4*)g_final)[ln7 + 64 * j]; xr[64 * j] = xr[64 * j] * gg * rstd; }
    }
}

extern "C" void kernel_launch(void* const* d_in, const int* in_sizes, int n_in, void* d_out, int out_size, void* d_ws, size_t ws_size, hipStream_t stream) {
    static int grid_blocks = 0;
    if (grid_blocks == 0) {
        if (n_in != 18 || in_sizes[0] != MTOK * DM || out_size != MTOK * DM || ws_size < WS_END) {
            fprintf(stderr, "kernel_launch: unexpected shapes: n_in %d in0 %d out %d ws %zu (need >= %zu)\n", n_in, n_in > 0 ? in_sizes[0] : -1, out_size, ws_size, (size_t)WS_END);
            grid_blocks = -1; return; }
        int dev = 0, cus = 0, per_cu = 0;
        hipGetDevice(&dev);
        hipDeviceGetAttribute(&cus, hipDeviceAttributeMultiprocessorCount, dev);
        if (hipFuncSetAttribute((const void*)fwd_megakernel, hipFuncAttributeMaxDynamicSharedMemorySize, LDS_BYTES) != hipSuccess) { fprintf(stderr, "kernel_launch: hipFuncSetAttribute failed\n"); grid_blocks = -1; return; }
        if (hipOccupancyMaxActiveBlocksPerMultiprocessor(&per_cu, (const void*)fwd_megakernel, 512, LDS_BYTES) != hipSuccess || per_cu < 1) { per_cu = 1; (void)hipGetLastError(); }
        grid_blocks = cus * per_cu;
    }
    if (grid_blocks < 0) return;
    Args a{};
    for (int i = 0; i < 18; ++i) a.in[i] = (const float*)d_in[i];
    a.out = (float*)d_out; a.ws = (unsigned char*)d_ws;
    void* args[] = {&a};
    hipError_t e = hipLaunchCooperativeKernel((const void*)fwd_megakernel, dim3(grid_blocks), dim3(512), args, LDS_BYTES, stream);
    if (e != hipSuccess) fprintf(stderr, "cooperative launch failed: %s (grid %d)\n", hipGetErrorString(e), grid_blocks);
}
```

```cpp
#include <hip/hip_runtime.h>
#include <hip/hip_cooperative_groups.h>
#include <cstdio>
#include <cstdint>
namespace cg = cooperative_groups;
#ifndef PROBE_DUP
#define PROBE_DUP 0
#endif

constexpr int BATCH = 8, SEQ = 8192, DM = 1024, MTOK = BATCH * SEQ;
constexpr int POOLW = 512, INW = 5632, DFF = 4096, NHEAD = 8;
constexpr float NORM_EPS = 1e-6f, SUBLN_EPS = 1e-5f, LAMBDA_INIT = 0.2f;
constexpr float QSCALE = 0.125f * 1.4426950408889634f;

typedef unsigned short bf16_t;
typedef short bf16x8 __attribute__((ext_vector_type(8)));
typedef short s16x4 __attribute__((ext_vector_type(4)));
typedef float f32x4 __attribute__((ext_vector_type(4)));
typedef float f32x2 __attribute__((ext_vector_type(2)));
typedef float f32x16 __attribute__((ext_vector_type(16)));
typedef unsigned u32x4 __attribute__((ext_vector_type(4)));
typedef unsigned u32x2 __attribute__((ext_vector_type(2)));
#define LAS __attribute__((address_space(3)))

typedef __bf16 bf16x2_t __attribute__((ext_vector_type(2)));
__device__ __forceinline__ unsigned cvt_pk_bf16(float lo, float hi) { f32x2 v = {lo, hi}; bf16x2_t b = __builtin_convertvector(v, bf16x2_t); return __builtin_bit_cast(unsigned, b); }
__device__ __forceinline__ float bf_lo(unsigned w) { return __uint_as_float(w << 16); }
__device__ __forceinline__ float bf_hi(unsigned w) { return __uint_as_float(w & 0xffff0000u); }
template <int K> __device__ __forceinline__ float swz_xor(float v) { return __int_as_float(__builtin_amdgcn_ds_swizzle(__float_as_int(v), (K << 10) | 0x1F)); }
__device__ __forceinline__ float xor32_sum(float v) { auto rr = __builtin_amdgcn_permlane32_swap(__float_as_uint(v), __float_as_uint(v), false, false); return __uint_as_float(rr[0]) + __uint_as_float(rr[1]); }
__device__ __forceinline__ float wave_sum(float v) {
    v += swz_xor<1>(v); v += swz_xor<2>(v); v += swz_xor<4>(v); v += swz_xor<8>(v); v += swz_xor<16>(v);
    return xor32_sum(v);
}
__device__ __forceinline__ float fast_sigmoid(float x) { return __builtin_amdgcn_rcpf(1.0f + __builtin_amdgcn_exp2f(-1.4426950408889634f * x)); }

constexpr size_t MiB = 1u << 20;
constexpr size_t WS_ROPE = 1 * MiB, WS_RS1 = 2 * MiB, WS_RS2 = 6 * MiB;
constexpr size_t WS_WIN = 10 * MiB, WS_WATT = 22 * MiB, WS_WO = 24 * MiB, WS_WUP = 26 * MiB, WS_WDN = 34 * MiB, WS_WCOMB = 42 * MiB;
constexpr size_t WS_H = 64 * MiB, WS_MP = WS_H;
constexpr size_t WS_Q = 192 * MiB, WS_ATT = WS_Q;
constexpr size_t WS_K = 320 * MiB, WS_MG = WS_K;
constexpr size_t WS_V = 448 * MiB;
constexpr size_t WS_G = 576 * MiB, WS_XG = WS_G;
constexpr size_t WS_U = 832 * MiB, WS_P = 896 * MiB;
constexpr size_t WS_HB = 64 * MiB;
constexpr size_t WS_END = 960 * MiB;
constexpr int LDS_BYTES = 147456;

namespace pg8 {
constexpr int BM = 256, BK = 64, HALF = 128, HTB = HALF * BK * 2, STAGE_BYTES = 8 * HTB, NXCD = 8, WGM = 8;
__host__ __device__ __forceinline__ int lds_byte(int r, int c) { const int st = (r >> 4) * 2 + (c >> 5), rr = r & 15, cc = c & 31, ob = rr * 64 + cc * 2; return st * 1024 + (ob ^ (((ob >> 9) & 1) << 5)); }
__host__ __device__ __forceinline__ void stage_rc(int b, int& R, int& C) { const int st = b / 1024, sb = b % 1024, swz = sb ^ (((sb >> 9) & 1) << 5); R = (st >> 1) * 16 + swz / 64; C = (st & 1) * 32 + (swz % 64) / 2; }
__host__ __device__ __forceinline__ int perm32(int rho) { const int n = rho >> 4, i = rho & 15; return 8 * (i >> 2) + 4 * n + (i & 3); }

struct Unit { int pm, pn; };
struct Gemm { const bf16_t* A; const bf16_t* Bt; int M, N, K; };

struct StaticOrder {
    int nM, nN, nwg, G, c;
    __host__ __device__ void init(int M, int N, int G_, int c_) { nM = M / BM; nN = N / BM; nwg = nM * nN; G = G_; c = c_; }
    __host__ __device__ bool next(int i, Unit& u) const {
        const long L = (long)i * G + c; if (L >= nwg) return false;
        int wgid = (int)L; { const int q = nwg / NXCD, r = nwg % NXCD, xcd = wgid % NXCD, off = wgid / NXCD; wgid = (xcd < r ? xcd * (q + 1) : r * (q + 1) + (xcd - r) * q) + off; }
        const int nig = WGM * nN, gid = wgid / nig, fm = gid * WGM, gsz = (nM - fm) < WGM ? (nM - fm) : WGM;
        u.pm = fm + ((wgid % nig) % gsz); u.pn = (wgid % nig) / gsz; return true;
    }
    __device__ __forceinline__ void a_ready(const Unit&) const {}
    __device__ __forceinline__ void done(const Unit&) const {}
};


struct EpiProj {
    static constexpr bool PERM = true, AFTER_DRAIN = false;
    bf16_t *U, *Q, *Kb, *V, *G; const float* bgate; const f32x2* rope;
    __device__ __forceinline__ void operator()(const f32x4 (&acc)[2][2][4][2], const Unit& u, int wr, int wc, int fr, int fq) const {
        const int cb = u.pn * BM, row0 = u.pm * BM + wr * 64 + fr, lc = wc * 32 + 8 * fq;
        if (cb >= 512 && cb < 2560) {
            bf16_t* dst = (cb < 1536) ? Q : Kb; const int dcol = ((cb < 1536) ? cb - 512 : cb - 1536) + lc;
            const bool rot = ((wc & 1) == 0);
#pragma unroll
            for (int ai = 0; ai < 2; ++ai) {
                f32x4 cs[4][4];
                if (rot) {
#pragma unroll
                    for (int m = 0; m < 4; ++m) { const int pos = (row0 + ai * HALF + m * 16) & (SEQ - 1);
#pragma unroll
                        for (int j = 0; j < 4; ++j) cs[m][j] = *(const f32x4*)(rope + pos * 8 + 2 * j); }
                }
#pragma unroll
                for (int m = 0; m < 4; ++m) {
                    const int row = row0 + ai * HALF + m * 16;
#pragma unroll
                    for (int bj = 0; bj < 2; ++bj) {
                        f32x4 v0 = acc[ai][bj][m][0], v1 = acc[ai][bj][m][1];
                        if (rot) {
                            float a[8] = {v0[0], v0[1], v0[2], v0[3], v1[0], v1[1], v1[2], v1[3]};
#pragma unroll
                            for (int j = 0; j < 8; ++j) {
                                const float p = swz_xor<16>(a[j]);
                                const float c = cs[m][j >> 1][(j & 1) * 2], s = cs[m][j >> 1][(j & 1) * 2 + 1];
                                const float r0 = a[j] * c - p * s, r1 = a[j] * c + p * s;
                                a[j] = (fq == 0) ? r0 : ((fq == 1) ? r1 : a[j]);
                            }
                            v0 = (f32x4){a[0], a[1], a[2], a[3]}; v1 = (f32x4){a[4], a[5], a[6], a[7]};
                        }
                        if (cb < 1536) { v0 = v0 * QSCALE; v1 = v1 * QSCALE; }
                        u32x4 w; w.x = cvt_pk_bf16(v0[0], v0[1]); w.y = cvt_pk_bf16(v0[2], v0[3]); w.z = cvt_pk_bf16(v1[0], v1[1]); w.w = cvt_pk_bf16(v1[2], v1[3]);
                        if (cb < 1536) *(u32x4*)(dst + (size_t)row * DM + dcol + bj * HALF) = w;
                        else *(u32x4*)(dst + ((size_t)((row >> 13) * NHEAD + ((cb - 1536) >> 7) + bj) * SEQ + (row & (SEQ - 1))) * 128 + lc) = w;
                    }
                }
                asm volatile("" ::: "memory");
            }
        } else if (cb >= 3584) {
            const int gcol = cb - 3584 + lc;
            f32x4 bv[2][2];
#pragma unroll
            for (int bj = 0; bj < 2; ++bj)
#pragma unroll
                for (int n = 0; n < 2; ++n) bv[bj][n] = *(const f32x4*)(bgate + gcol + bj * HALF + 4 * n);
#pragma unroll
            for (int ai = 0; ai < 2; ++ai)
#pragma unroll
                for (int m = 0; m < 4; ++m) {
                    const int row = row0 + ai * HALF + m * 16;
#pragma unroll
                    for (int bj = 0; bj < 2; ++bj) {
                        const f32x4 v0 = acc[ai][bj][m][0] + bv[bj][0], v1 = acc[ai][bj][m][1] + bv[bj][1];
                        u32x4 w; w.x = cvt_pk_bf16(fast_sigmoid(v0[0]), fast_sigmoid(v0[1])); w.y = cvt_pk_bf16(fast_sigmoid(v0[2]), fast_sigmoid(v0[3]));
                        w.z = cvt_pk_bf16(fast_sigmoid(v1[0]), fast_sigmoid(v1[1])); w.w = cvt_pk_bf16(fast_sigmoid(v1[2]), fast_sigmoid(v1[3]));
                        *(u32x4*)(G + (size_t)row * (2 * DM) + gcol + bj * HALF) = w;
                    }
                }
        } else if (cb >= 2560) {
#pragma unroll
            for (int ai = 0; ai < 2; ++ai)
#pragma unroll
                for (int m = 0; m < 4; ++m) {
                    const int row = row0 + ai * HALF + m * 16;
#pragma unroll
                    for (int bj = 0; bj < 2; ++bj) {
                        const f32x4 v0 = acc[ai][bj][m][0], v1 = acc[ai][bj][m][1];
                        u32x4 w; w.x = cvt_pk_bf16(v0[0], v0[1]); w.y = cvt_pk_bf16(v0[2], v0[3]); w.z = cvt_pk_bf16(v1[0], v1[1]); w.w = cvt_pk_bf16(v1[2], v1[3]);
                        *(u32x4*)(V + ((size_t)((row >> 13) * NHEAD + ((cb - 2560) >> 7) + bj) * SEQ + (row & (SEQ - 1))) * 128 + lc) = w;
                    }
                }
        } else {
            bf16_t* dst = U; const int ld = POOLW; const int dcol = cb + lc;
#pragma unroll
            for (int ai = 0; ai < 2; ++ai)
#pragma unroll
                for (int m = 0; m < 4; ++m) {
                    const int row = row0 + ai * HALF + m * 16;
#pragma unroll
                    for (int bj = 0; bj < 2; ++bj) {
                        const f32x4 v0 = acc[ai][bj][m][0], v1 = acc[ai][bj][m][1];
                        u32x4 w; w.x = cvt_pk_bf16(v0[0], v0[1]); w.y = cvt_pk_bf16(v0[2], v0[3]); w.z = cvt_pk_bf16(v1[0], v1[1]); w.w = cvt_pk_bf16(v1[2], v1[3]);
                        *(u32x4*)(dst + (size_t)row * ld + dcol + bj * HALF) = w;
                    }
                }
        }
    }
};

template <bool ADD> struct EpiGate {
    static constexpr bool PERM = true, AFTER_DRAIN = false;
    const bf16_t* G; int goff; const bf16_t* prev; bf16_t* O;
    __device__ __forceinline__ void operator()(const f32x4 (&acc)[2][2][4][2], const Unit& u, int wr, int wc, int fr, int fq) const {
        const int row0 = u.pm * BM + wr * 64 + fr, col0 = u.pn * BM + wc * 32 + 8 * fq;
#pragma unroll
        for (int ai = 0; ai < 2; ++ai) {
            u32x4 gq[4][2], pq[4][2];
#pragma unroll
            for (int m = 0; m < 4; ++m)
#pragma unroll
                for (int bj = 0; bj < 2; ++bj) { const int row = row0 + ai * HALF + m * 16;
                    gq[m][bj] = *(const u32x4*)(G + (size_t)row * (2 * DM) + goff + col0 + bj * HALF);
                    if (ADD) pq[m][bj] = *(const u32x4*)(prev + (size_t)row * DM + col0 + bj * HALF); }
#pragma unroll
            for (int m = 0; m < 4; ++m) {
                const int row = row0 + ai * HALF + m * 16;
#pragma unroll
                for (int bj = 0; bj < 2; ++bj) {
                    const u32x4 g = gq[m][bj];
                    f32x4 v0 = acc[ai][bj][m][0], v1 = acc[ai][bj][m][1];
                    v0 = v0 * (f32x4){bf_lo(g.x), bf_hi(g.x), bf_lo(g.y), bf_hi(g.y)};
                    v1 = v1 * (f32x4){bf_lo(g.z), bf_hi(g.z), bf_lo(g.w), bf_hi(g.w)};
                    if (ADD) {
                        const u32x4 p = pq[m][bj];
                        v0 = v0 + (f32x4){bf_lo(p.x), bf_hi(p.x), bf_lo(p.y), bf_hi(p.y)};
                        v1 = v1 + (f32x4){bf_lo(p.z), bf_hi(p.z), bf_lo(p.w), bf_hi(p.w)};
                    }
                    u32x4 w; w.x = cvt_pk_bf16(v0[0], v0[1]); w.y = cvt_pk_bf16(v0[2], v0[3]); w.z = cvt_pk_bf16(v1[0], v1[1]); w.w = cvt_pk_bf16(v1[2], v1[3]);
                    *(u32x4*)(O + (size_t)row * DM + col0 + bj * HALF) = w;
                }
            }
            asm volatile("" ::: "memory");
        }
    }
};

template <bool XG> struct EpiRes {
    static constexpr bool PERM = false, AFTER_DRAIN = false;
    const float* xi; float* xo; bf16_t* xg; const float* g; float* rowss;
    __device__ __forceinline__ void operator()(const f32x4 (&acc)[2][2][4][2], const Unit& u, int wr, int wc, int fr, int fq) const {
        const int col0 = u.pn * BM + wc * 32 + 4 * fq;
        f32x4 gv[2][2];
        if (XG) {
#pragma unroll
            for (int bj = 0; bj < 2; ++bj)
#pragma unroll
                for (int n = 0; n < 2; ++n) gv[bj][n] = *(const f32x4*)(g + col0 + bj * HALF + n * 16);
        }
#pragma unroll
        for (int ai = 0; ai < 2; ++ai) {
            f32x4 xv[4][2][2];
#pragma unroll
            for (int m = 0; m < 4; ++m) { const size_t off = (size_t)(u.pm * BM + ai * HALF + wr * 64 + m * 16 + fr) * DM + col0;
#pragma unroll
                for (int bj = 0; bj < 2; ++bj)
#pragma unroll
                    for (int n = 0; n < 2; ++n) xv[m][bj][n] = *(const f32x4*)(xi + off + bj * HALF + n * 16); }
#pragma unroll
            for (int m = 0; m < 4; ++m) {
                const int row = u.pm * BM + ai * HALF + wr * 64 + m * 16 + fr; const size_t off = (size_t)row * DM + col0;
                float ss = 0.f;
#pragma unroll
                for (int bj = 0; bj < 2; ++bj)
#pragma unroll
                    for (int n = 0; n < 2; ++n) {
                        const f32x4 v = acc[ai][bj][m][n] + xv[m][bj][n];
                        *(f32x4*)(xo + off + bj * HALF + n * 16) = v;
                        ss += (v[0] * v[0] + v[1] * v[1]) + (v[2] * v[2] + v[3] * v[3]);
                        if (XG) { const f32x4 w = v * gv[bj][n]; u32x2 p; p.x = cvt_pk_bf16(w[0], w[1]); p.y = cvt_pk_bf16(w[2], w[3]); *(u32x2*)(xg + off + bj * HALF + n * 16) = p; }
                    }
                ss += swz_xor<16>(ss); ss = xor32_sum(ss);
                if (fq == 0) rowss[(size_t)row * 16 + u.pn * 4 + wc] = ss;
            }
            asm volatile("" ::: "memory");
        }
    }
};

struct EpiUp {
    static constexpr bool PERM = true, AFTER_DRAIN = false;
    const float* rowss; bf16_t* O;
    __device__ __forceinline__ void operator()(const f32x4 (&acc)[2][2][4][2], const Unit& u, int wr, int wc, int fr, int fq) const {
        const int row0 = u.pm * BM + wr * 64 + fr, col0 = u.pn * BM + wc * 32 + 8 * fq;
        f32x4 pz[2][4]; float rstd[2][4];
#pragma unroll
        for (int ai = 0; ai < 2; ++ai)
#pragma unroll
            for (int m = 0; m < 4; ++m) pz[ai][m] = *(const f32x4*)(rowss + (size_t)(row0 + ai * HALF + m * 16) * 16 + 4 * fq);
#pragma unroll
        for (int ai = 0; ai < 2; ++ai)
#pragma unroll
            for (int m = 0; m < 4; ++m) { float ss = (pz[ai][m][0] + pz[ai][m][1]) + (pz[ai][m][2] + pz[ai][m][3]); ss += swz_xor<16>(ss); ss = xor32_sum(ss);
                rstd[ai][m] = __builtin_amdgcn_rsqf(ss * (1.0f / DM) + NORM_EPS); }
#pragma unroll
        for (int ai = 0; ai < 2; ++ai)
#pragma unroll
            for (int m = 0; m < 4; ++m) {
                const int row = row0 + ai * HALF + m * 16;
#pragma unroll
                for (int bj = 0; bj < 2; ++bj) {
                    f32x4 v0 = acc[ai][bj][m][0] * rstd[ai][m], v1 = acc[ai][bj][m][1] * rstd[ai][m];
#pragma unroll
                    for (int e = 0; e < 4; ++e) { const float a = fmaxf(v0[e], 0.f), b = fmaxf(v1[e], 0.f); v0[e] = a * a; v1[e] = b * b; }
                    u32x4 w; w.x = cvt_pk_bf16(v0[0], v0[1]); w.y = cvt_pk_bf16(v0[2], v0[3]); w.z = cvt_pk_bf16(v1[0], v1[1]); w.w = cvt_pk_bf16(v1[2], v1[3]);
                    *(u32x4*)(O + (size_t)row * DFF + col0 + bj * HALF) = w;
                }
            }
    }
};

template <class Epi, class Sched, bool ALIGN_EPI = false, bool SP2 = false>
__device__ __forceinline__ void gemm_phase(LAS unsigned char* lds, const Gemm g, const Sched& S, const Epi& E) {
    int tid_ = threadIdx.x; asm volatile("" : "+v"(tid_));
    const int tid = tid_, wid = __builtin_amdgcn_readfirstlane(tid >> 6), lane = tid & 63, wr = wid >> 2, wc = wid & 3, fr = lane & 15, fq = lane >> 4;
    const int K = g.K, nt = K / BK;
    unsigned voffA[2], voffB[2];
#pragma unroll
    for (int i = 0; i < 2; ++i) { int R, C; stage_rc(tid * 16 + i * 8192, R, C); const int Rb = Epi::PERM ? ((R & ~31) + perm32(R & 31)) : R;
        voffA[i] = (unsigned)(R * K + C) * 2u; voffB[i] = (unsigned)(Rb * K + C) * 2u; }
    const size_t kstep = (size_t)(BK * 2);
    const size_t hstep = (size_t)HALF * K * 2;
    const size_t tstep = 2 * hstep;
    const unsigned ldsw = (unsigned)wid * 1024u;
    const int aoff = lds_byte(wr * 64 + fr, fq * 8), boff = lds_byte(wc * 32 + fr, fq * 8);
#define PG8_SA(b, h) (((b) * 2 + (h)) * HTB)
#define PG8_SB(b, h) ((4 + (b) * 2 + (h)) * HTB)
#define PG8_STAGE(bufoff, gbase, voff) do { _Pragma("unroll") for (int _i = 0; _i < 2; ++_i) \
        __builtin_amdgcn_global_load_lds((const unsigned*)((const char*)(gbase) + (voff)[_i]), (LAS unsigned*)(lds + (bufoff) + ldsw + _i * 8192), 16, 0, 0); } while (0)
#define PG8_LDA(dst, b, h) do { _Pragma("unroll") for (int m = 0; m < 4; ++m) _Pragma("unroll") for (int k = 0; k < 2; ++k) dst[m][k] = *(const LAS bf16x8*)(lds + PG8_SA(b, h) + aoff + m * 2048 + k * 1024); } while (0)
#define PG8_LDB(dst, b, h) do { _Pragma("unroll") for (int n = 0; n < 2; ++n) _Pragma("unroll") for (int k = 0; k < 2; ++k) dst[n][k] = *(const LAS bf16x8*)(lds + PG8_SB(b, h) + boff + n * 2048 + k * 1024); } while (0)
#define PG8_MMA(ai, bj, At, Bt) do { __builtin_amdgcn_s_setprio(1); _Pragma("unroll") for (int m = 0; m < 4; ++m) _Pragma("unroll") for (int n = 0; n < 2; ++n) _Pragma("unroll") for (int k = 0; k < 2; ++k) \
        acc[ai][bj][m][n] = __builtin_amdgcn_mfma_f32_16x16x32_bf16(Bt[n][k], At[m][k], acc[ai][bj][m][n], 0, 0, 0); __builtin_amdgcn_s_setprio(0); } while (0)
#define PG8_WAIT_V(n) asm volatile("s_waitcnt vmcnt(" #n ")" ::: "memory")
#define PG8_WAIT_L(n) asm volatile("s_waitcnt lgkmcnt(" #n ")" ::: "memory")
#define PG8_BAR __builtin_amdgcn_s_barrier()
#define PG8_SCHED __builtin_amdgcn_sched_barrier(0)
    Unit cur, nxt; int ui = 0;
    if (!S.next(0, cur)) return;
    f32x4 acc[2][2][4][2];
#pragma unroll
    for (int a = 0; a < 2; ++a)
#pragma unroll
        for (int b = 0; b < 2; ++b)
#pragma unroll
            for (int m = 0; m < 4; ++m)
#pragma unroll
                for (int n = 0; n < 2; ++n) acc[a][b][m][n] = (f32x4){0.f, 0.f, 0.f, 0.f};
    bf16x8 At[4][2], B0[2][2], B1[2][2];
    const char* cA = (const char*)g.A + (size_t)cur.pm * tstep; const char* cB = (const char*)g.Bt + (size_t)cur.pn * tstep;
    S.a_ready(cur);
    if constexpr (SP2) {
        PG8_STAGE(PG8_SB(0, 0), cB, voffB); PG8_STAGE(PG8_SB(0, 1), cB + hstep, voffB); PG8_STAGE(PG8_SA(0, 0), cA, voffA); PG8_STAGE(PG8_SA(0, 1), cA + hstep, voffA);
        if (wr == 1) PG8_BAR;
        PG8_WAIT_V(2); PG8_BAR;
        PG8_STAGE(PG8_SB(1, 0), cB + kstep, voffB); PG8_STAGE(PG8_SA(1, 0), cA + kstep, voffA); PG8_STAGE(PG8_SB(1, 1), cB + hstep + kstep, voffB);
        PG8_WAIT_V(6); PG8_BAR;
    } else {
        PG8_STAGE(PG8_SB(0, 0), cB, voffB); PG8_STAGE(PG8_SA(0, 0), cA, voffA); PG8_STAGE(PG8_SB(0, 1), cB + hstep, voffB); PG8_STAGE(PG8_SA(0, 1), cA + hstep, voffA);
        if (wr == 1) PG8_BAR;
        PG8_WAIT_V(4); PG8_BAR;
        PG8_STAGE(PG8_SB(1, 0), cB + kstep, voffB); PG8_STAGE(PG8_SA(1, 0), cA + kstep, voffA); PG8_STAGE(PG8_SB(1, 1), cB + hstep + kstep, voffB);
        PG8_WAIT_V(6); PG8_BAR;
    }
    for (;;) {
        const bool has_next = S.next(ui + 1, nxt);
        const char* nA = has_next ? (const char*)g.A + (size_t)nxt.pm * tstep : cA; const char* nB = has_next ? (const char*)g.Bt + (size_t)nxt.pn * tstep : cB;
        for (int t = 0; t < nt; t += 2) {
            const bool last = (t == nt - 2);
            const char* a1 = cA + (size_t)(t + 1) * kstep;
            const char* a2 = last ? nA : cA + (size_t)(t + 2) * kstep; const char* b2 = last ? nB : cB + (size_t)(t + 2) * kstep;
            const char* a3 = a2 + kstep; const char* b3 = b2 + kstep;
            if (last && has_next) S.a_ready(nxt);
            if constexpr (SP2) {
            PG8_LDB(B0, 0, 0); PG8_LDB(B1, 0, 1); PG8_SCHED; PG8_LDA(At, 0, 0); PG8_STAGE(PG8_SA(1, 1), a1 + hstep, voffA);
            PG8_WAIT_V(8); PG8_WAIT_L(0); PG8_BAR; PG8_MMA(0, 0, At, B0); PG8_MMA(0, 1, At, B1); PG8_BAR; PG8_SCHED;
            PG8_LDA(At, 0, 1); PG8_STAGE(PG8_SB(0, 0), b2, voffB); PG8_STAGE(PG8_SB(0, 1), b2 + hstep, voffB); PG8_STAGE(PG8_SA(0, 0), a2, voffA);
            PG8_WAIT_V(8); PG8_WAIT_L(0); PG8_BAR; PG8_MMA(1, 0, At, B0); PG8_MMA(1, 1, At, B1); PG8_BAR; PG8_SCHED;
            PG8_LDB(B0, 1, 0); PG8_LDB(B1, 1, 1); PG8_SCHED; PG8_LDA(At, 1, 0); PG8_STAGE(PG8_SA(0, 1), a2 + hstep, voffA);
            PG8_WAIT_V(8); PG8_WAIT_L(0); PG8_BAR; PG8_MMA(0, 0, At, B0); PG8_MMA(0, 1, At, B1); PG8_BAR; PG8_SCHED;
            PG8_LDA(At, 1, 1); PG8_STAGE(PG8_SB(1, 0), b3, voffB); PG8_STAGE(PG8_SB(1, 1), b3 + hstep, voffB); PG8_STAGE(PG8_SA(1, 0), a3, voffA);
            PG8_WAIT_V(8); PG8_WAIT_L(0); PG8_BAR; PG8_MMA(1, 0, At, B0); PG8_MMA(1, 1, At, B1); PG8_BAR; PG8_SCHED;
            } else {
            PG8_LDB(B0, 0, 0); PG8_SCHED; PG8_LDA(At, 0, 0); PG8_STAGE(PG8_SA(1, 1), a1 + hstep, voffA);
            PG8_WAIT_L(8); PG8_BAR; PG8_WAIT_L(0); PG8_MMA(0, 0, At, B0); PG8_BAR; PG8_SCHED;
            PG8_LDB(B1, 0, 1); PG8_STAGE(PG8_SB(0, 0), b2, voffB);
            PG8_BAR; PG8_WAIT_L(0); PG8_MMA(0, 1, At, B1); PG8_BAR;
            PG8_LDA(At, 0, 1); PG8_STAGE(PG8_SA(0, 0), a2, voffA);
            PG8_BAR; PG8_WAIT_L(0); PG8_MMA(1, 0, At, B0); PG8_BAR; PG8_SCHED;
            PG8_STAGE(PG8_SB(0, 1), b2 + hstep, voffB);
            PG8_WAIT_V(6); PG8_BAR; PG8_MMA(1, 1, At, B1); PG8_BAR;
            PG8_LDB(B0, 1, 0); PG8_SCHED; PG8_LDA(At, 1, 0); PG8_STAGE(PG8_SA(0, 1), a2 + hstep, voffA);
            PG8_WAIT_L(8); PG8_BAR; PG8_WAIT_L(0); PG8_MMA(0, 0, At, B0); PG8_BAR; PG8_SCHED;
            PG8_LDB(B1, 1, 1); PG8_STAGE(PG8_SB(1, 0), b3, voffB);
            PG8_BAR; PG8_WAIT_L(0); PG8_MMA(0, 1, At, B1); PG8_BAR;
            PG8_LDA(At, 1, 1); PG8_STAGE(PG8_SA(1, 0), a3, voffA);
            PG8_BAR; PG8_WAIT_L(0); PG8_MMA(1, 0, At, B0); PG8_BAR; PG8_SCHED;
            PG8_STAGE(PG8_SB(1, 1), b3 + hstep, voffB);
            PG8_WAIT_V(6); PG8_BAR; PG8_MMA(1, 1, At, B1); PG8_BAR;
            }
        }
        if constexpr (ALIGN_EPI) { if (wr == 0) PG8_BAR; }
        if constexpr (!Epi::AFTER_DRAIN) { E(acc, cur, wr, wc, fr, fq); S.done(cur); }
        if (!has_next) break;
#pragma unroll
        for (int a = 0; a < 2; ++a)
#pragma unroll
            for (int b = 0; b < 2; ++b)
#pragma unroll
                for (int m = 0; m < 4; ++m)
#pragma unroll
                    for (int n = 0; n < 2; ++n) acc[a][b][m][n] = (f32x4){0.f, 0.f, 0.f, 0.f};
        cur = nxt; cA = nA; cB = nB; ++ui;
        if constexpr (ALIGN_EPI) { if (wr == 1) PG8_BAR; }
    }
    PG8_WAIT_V(0);
    if constexpr (!ALIGN_EPI) { if (wr == 0) PG8_BAR; }
    PG8_BAR;
#undef PG8_SA
#undef PG8_SB
#undef PG8_STAGE
#undef PG8_LDA
#undef PG8_LDB
#undef PG8_MMA
#undef PG8_WAIT_V
#undef PG8_WAIT_L
#undef PG8_BAR
#undef PG8_SCHED
}
}

namespace att {
constexpr int LD = DM, LDK = 128, KVBLK = 64, UROWS = 128;
constexpr float C2 = 0.125f * 1.4426950408889634f;
constexpr float THRL = 8.f * 1.4426950408889634f;
constexpr int SHM_V = 16384, SHM_K = 16384;
constexpr int OFF_V = 0, OFF_K = 2 * SHM_V, OFF_WS = OFF_K + 2 * SHM_K, OFF_OST = OFF_WS + 8 * 64 * 4, ATT_LDS = OFF_OST + 4 * 32 * 128 * 4;
static_assert(ATT_LDS <= LDS_BYTES, "attention LDS");
#define KSWZ(row, colB) ((row) * 256 + ((colB) ^ (((row) & 7) << 4)))
#define SBAR() __builtin_amdgcn_sched_barrier(0)
__device__ __forceinline__ int crow(int r, int hi) { return (r & 3) + 8 * (r >> 2) + 4 * hi; }

__device__ __forceinline__ float rowmax(const f32x16& p0, const f32x16& p1) {
  float pmax = fmaxf(p0[0], p1[0]);
#pragma unroll
  for (int r = 1; r < 16; ++r) pmax = fmaxf(fmaxf(pmax, p0[r]), p1[r]);
  auto rr = __builtin_amdgcn_permlane32_swap(__float_as_uint(pmax), __float_as_uint(pmax), false, false);
  return fmaxf(__uint_as_float(rr[0]), __uint_as_float(rr[1]));
}
__device__ __forceinline__ void startSM(f32x16& p0, f32x16& p1, float& m_run, bool& slow) {
  const float rm = rowmax(p0, p1);
  slow = false; m_run = 0.f;
  if (__builtin_expect(__any(fabsf(rm) > THRL), 0)) { slow = true; m_run = rm;
#pragma unroll
    for (int r = 0; r < 16; ++r) { p0[r] -= rm; p1[r] -= rm; } }
#pragma unroll
  for (int r = 0; r < 16; ++r) p0[r] = __builtin_amdgcn_exp2f(p0[r]);
}
__device__ __forceinline__ void partialSM(f32x16& p0, f32x16& p1, float& m_run, bool& slow, float& alpha) {
  if (__builtin_expect(slow, 0)) {
#pragma unroll
    for (int r = 0; r < 16; ++r) { p0[r] -= m_run; p1[r] -= m_run; } }
  const float rm = rowmax(p0, p1);
  alpha = 1.f;
  if (__builtin_expect(__any(rm > THRL), 0)) {
    const float dl = fmaxf(rm, 0.f); m_run += dl; slow = true;
#pragma unroll
    for (int r = 0; r < 16; ++r) { p0[r] -= dl; p1[r] -= dl; }
    alpha = __builtin_amdgcn_exp2f(-dl);
  }
#pragma unroll
  for (int r = 0; r < 16; ++r) p0[r] = __builtin_amdgcn_exp2f(p0[r]);
}
__device__ __forceinline__ void finishSM(f32x16& p0, f32x16& p1, bf16x8& pa0, bf16x8& pa1, bf16x8& pa2, bf16x8& pa3) {
#pragma unroll
  for (int r = 0; r < 16; ++r) p1[r] = __builtin_amdgcn_exp2f(p1[r]);
#define PK8(P, B, OUT) do { u32x4 w = {cvt_pk_bf16(P[B], P[B + 1]), cvt_pk_bf16(P[B + 2], P[B + 3]), cvt_pk_bf16(P[B + 4], P[B + 5]), cvt_pk_bf16(P[B + 6], P[B + 7])}; OUT = __builtin_bit_cast(bf16x8, w); } while (0)
  PK8(p0, 0, pa0); PK8(p0, 8, pa1); PK8(p1, 0, pa2); PK8(p1, 8, pa3);
#undef PK8
}
__device__ __forceinline__ void qkt(f32x16& p0, f32x16& p1, const char* Ks, const bf16x8* qr, int r32, int kcb) {
  p0 = f32x16{}; p1 = f32x16{};
#pragma unroll
  for (int d0 = 0; d0 < 4; ++d0) { const int cb = kcb + d0 * 32;
    bf16x8 b0 = *reinterpret_cast<const bf16x8*>(Ks + KSWZ(r32, cb));
    bf16x8 b1 = *reinterpret_cast<const bf16x8*>(Ks + KSWZ(32 + r32, cb));
    p0 = __builtin_amdgcn_mfma_f32_32x32x16_bf16(b0, qr[d0], p0, 0, 0, 0);
    p1 = __builtin_amdgcn_mfma_f32_32x32x16_bf16(b1, qr[d0], p1, 0, 0, 0);
    if (d0 == 1) SBAR(); }
}
__device__ __forceinline__ int v_st(int k, int c) { return (c >> 5) * 4096 + k * 64 + (c & 31) * 2; }
__device__ __forceinline__ int v_rd_base(int lane) { return ((lane >> 4) & 1) * 32 + (lane & 3) * 8 + (4 * (lane >> 5) + ((lane & 15) >> 2)) * 64; }
constexpr int v_rd_off(int d0, int ks, int half) { return d0 * 4096 + ks * 1024 + half * 512; }
typedef short v4i16_t __attribute__((ext_vector_type(4)));
typedef LAS const char* lds_cptr;
__device__ __forceinline__ s16x4 vtr(lds_cptr p) { return __builtin_bit_cast(s16x4, __builtin_amdgcn_ds_read_tr16_b64_v4i16((LAS v4i16_t*)p)); }
#define PVRD(KS) do { _Pragma("unroll") for (int d = 0; d < 4; ++d) { l[d] = vtr(vp + v_rd_off(d, KS, 0)); h[d] = vtr(vp + v_rd_off(d, KS, 1)); } } while (0)
#define PVPK(L, H) (bf16x8){L[0], L[1], L[2], L[3], H[0], H[1], H[2], H[3]}
#define PVMM(PA) do { lacc = __builtin_amdgcn_mfma_f32_32x32x16_bf16(PA, ones, lacc, 0, 0, 0); _Pragma("unroll") for (int d = 0; d < 4; ++d) o[d] = __builtin_amdgcn_mfma_f32_32x32x16_bf16(PA, PVPK(l[d], h[d]), o[d], 0, 0, 0); } while (0)
__device__ __forceinline__ void pv_tile(f32x16* o, f32x16& lacc, lds_cptr vp, bf16x8 pa0, bf16x8 pa1, bf16x8 pa2, bf16x8 pa3) {
  const bf16x8 ones = {16256, 16256, 16256, 16256, 16256, 16256, 16256, 16256};
  s16x4 l[4], h[4];
  PVRD(0); PVMM(pa0); SBAR();
  PVRD(1); PVMM(pa1); SBAR();
  PVRD(2); PVMM(pa2); SBAR();
  PVRD(3); PVMM(pa3);
}
#undef PVRD
#undef PVPK
#undef PVMM

__device__ __forceinline__ void attn_unit(const bf16_t* Qb, const bf16_t* __restrict__ Kh, const bf16_t* __restrict__ Vh, bf16_t* Ob, int seq, float lam, const float* __restrict__ gsub, char* lds) {
  int tid_ = threadIdx.x; asm volatile("" : "+v"(tid_));
  const int tid = tid_, lane = tid & 63, r32 = lane & 31, hi = lane >> 5;
  const int wid = __builtin_amdgcn_readfirstlane(tid >> 6), mc = wid >> 2, wq = wid & 3;
  char* V_lds = lds + OFF_V; char* K_lds = lds + OFF_K;
  float* al_l = (float*)(lds + OFF_WS) + wid * 64;
  float m_run = 0.f; bool slow = false; f32x16 o[4] = {}, lacc = {}; bf16x8 qr[4];
  const bf16_t* Qw = Qb + (long)(wq * 32 + r32) * LD + mc * 64 + hi * 8;
#pragma unroll
  for (int d0 = 0; d0 < 4; ++d0) qr[d0] = *reinterpret_cast<const bf16x8*>(Qw + d0 * 16);
  const int kcb = mc * 128 + hi * 16;
  const int sr = tid >> 4, sc = (tid & 15) * 8, vst0 = v_st(sr, sc), vst1 = v_st(32 + sr, sc);
  const lds_cptr vb0 = (lds_cptr)V_lds + v_rd_base(lane);
  struct { bf16x8 vs0, vs1, ks0, ks1; } sr_[2];
#define SLOAD(i, k0) do { sr_[i].vs0 = *reinterpret_cast<const bf16x8*>(&Vh[(long)((k0) + sr) * LDK + sc]); sr_[i].vs1 = *reinterpret_cast<const bf16x8*>(&Vh[(long)((k0) + 32 + sr) * LDK + sc]); \
    sr_[i].ks0 = *reinterpret_cast<const bf16x8*>(&Kh[(long)((k0) + sr) * LDK + sc]); sr_[i].ks1 = *reinterpret_cast<const bf16x8*>(&Kh[(long)((k0) + 32 + sr) * LDK + sc]); } while (0)
#define SWRITE(b, i) do { *(bf16x8*)(V_lds + (b) * SHM_V + vst0) = sr_[i].vs0;          \
    *(bf16x8*)(V_lds + (b) * SHM_V + vst1) = sr_[i].vs1; int kc = sc * 2;               \
    *(bf16x8*)(K_lds + (b) * SHM_K + KSWZ(sr, kc)) = sr_[i].ks0;                       \
    *(bf16x8*)(K_lds + (b) * SHM_K + KSWZ(32 + sr, kc)) = sr_[i].ks1; } while (0)
#define SWAIT() asm volatile("s_waitcnt vmcnt(4)" ::: "memory")
#define RESC(a) do { if (__any((a) < 1.f)) { if (hi == 0) al_l[r32] = (a); asm volatile("s_waitcnt lgkmcnt(0)" ::: "memory"); \
    _Pragma("unroll") for (int r = 0; r < 16; ++r) { const float f_ = al_l[crow(r, hi)]; lacc[r] *= f_; _Pragma("unroll") for (int d = 0; d < 4; ++d) o[d][r] *= f_; } } } while (0)
  f32x16 pA0, pA1, pB0, pB1; float alA = 1.f, alB = 1.f; bf16x8 pa0, pa1, pa2, pa3; const int NT = seq / KVBLK;
  constexpr int SE = 0, SO = 1;
  SLOAD(SE, 0); asm volatile("s_waitcnt vmcnt(0)" ::: "memory"); SWRITE(0, SE); __syncthreads();
  qkt(pA0, pA1, K_lds, qr, r32, kcb); startSM(pA0, pA1, m_run, slow);
  SLOAD(SO, KVBLK); SLOAD(SE, (2 < NT ? 2 : NT - 1) * KVBLK);
  SWAIT(); SWRITE(1, SO); __syncthreads();
  for (int j = 1; j + 1 < NT; j += 2) {
    SBAR(); qkt(pB0, pB1, K_lds + SHM_K, qr, r32, kcb);
    finishSM(pA0, pA1, pa0, pa1, pa2, pa3); SBAR();
    SLOAD(SO, (j + 2) * KVBLK); SBAR();
    pv_tile(o, lacc, vb0, pa0, pa1, pa2, pa3); partialSM(pB0, pB1, m_run, slow, alB);
    __syncthreads(); SWAIT(); SWRITE(0, SE);
    RESC(alB); __syncthreads();
    SBAR(); qkt(pA0, pA1, K_lds, qr, r32, kcb);
    finishSM(pB0, pB1, pa0, pa1, pa2, pa3); SBAR();
    SLOAD(SE, (j + 3 < NT ? j + 3 : NT - 1) * KVBLK); SBAR();
    pv_tile(o, lacc, vb0 + SHM_V, pa0, pa1, pa2, pa3); partialSM(pA0, pA1, m_run, slow, alA);
    __syncthreads(); SWAIT(); SWRITE(1, SO);
    RESC(alA); __syncthreads();
  }
  SBAR(); qkt(pB0, pB1, K_lds + SHM_K, qr, r32, kcb);
  if (wq < 2) {
#pragma unroll
    for (int r = 0; r < 16; ++r) { pB0[r] = -INFINITY; pB1[r] = -INFINITY; }
  }
  finishSM(pA0, pA1, pa0, pa1, pa2, pa3); SBAR();
  pv_tile(o, lacc, vb0, pa0, pa1, pa2, pa3); partialSM(pB0, pB1, m_run, slow, alB);
  __syncthreads(); RESC(alB);
  finishSM(pB0, pB1, pa0, pa1, pa2, pa3); SBAR();
  pv_tile(o, lacc, vb0 + SHM_V, pa0, pa1, pa2, pa3);
  float rli[16];
#pragma unroll
  for (int r = 0; r < 16; ++r) rli[r] = __builtin_amdgcn_rcpf(lacc[r]);
  float* ost = (float*)(lds + OFF_OST) + wq * (32 * 128);
  if (mc == 1) {
#pragma unroll
    for (int r = 0; r < 16; ++r)
#pragma unroll
      for (int d0 = 0; d0 < 4; ++d0) ost[crow(r, hi) * 128 + d0 * 32 + r32] = o[d0][r] * (rli[r] * lam);
  }
  __syncthreads();
  if (mc == 0) {
#pragma unroll
    for (int r = 0; r < 16; ++r)
#pragma unroll
      for (int d0 = 0; d0 < 4; ++d0) { const int ix = crow(r, hi) * 128 + d0 * 32 + r32; ost[ix] = o[d0][r] * rli[r] - ost[ix]; }
  }
  __syncthreads();
  { int tid2 = threadIdx.x; asm volatile("" : "+v"(tid2));
    const int row = tid2 >> 2, qt = tid2 & 3;
    const float* src = (const float*)(lds + OFF_OST) + row * 128 + qt * 32;
    f32x4 v[8]; float ss = 0.f;
#pragma unroll
    for (int i = 0; i < 8; ++i) { v[i] = *(const f32x4*)(src + 4 * i); ss += (v[i][0] * v[i][0] + v[i][1] * v[i][1]) + (v[i][2] * v[i][2] + v[i][3] * v[i][3]); }
    ss += swz_xor<1>(ss); ss += swz_xor<2>(ss);
    const float rs = __builtin_amdgcn_rsqf(ss * (1.0f / 128.0f) + SUBLN_EPS) * (1.0f - LAMBDA_INIT);
    bf16_t* dst = Ob + (long)row * LD + qt * 32;
#pragma unroll
    for (int i = 0; i < 4; ++i) {
      const f32x4 g0 = *(const f32x4*)(gsub + qt * 32 + 8 * i), g1 = *(const f32x4*)(gsub + qt * 32 + 8 * i + 4);
      const f32x4 a = v[2 * i] * g0 * rs, b = v[2 * i + 1] * g1 * rs;
      u32x4 w; w.x = cvt_pk_bf16(a[0], a[1]); w.y = cvt_pk_bf16(a[2], a[3]); w.z = cvt_pk_bf16(b[0], b[1]); w.w = cvt_pk_bf16(b[2], b[3]);
      *(u32x4*)(dst + 8 * i) = w;
    }
  }
  __syncthreads();
#undef SLOAD
#undef SWRITE
#undef SWAIT
#undef RESC
}
#undef SBAR
}

__device__ __forceinline__ unsigned f2bf(float f) { unsigned u = __builtin_bit_cast(unsigned, f); return (u + 0x7fffu + ((u >> 16) & 1u)) >> 16; }
__device__ __forceinline__ unsigned pk2(float lo, float hi) { return f2bf(lo) | (f2bf(hi) << 16); }
__device__ __forceinline__ void transpose_item(const float* __restrict__ W, int K, int N, bf16_t* WT, LAS float* scr, int item, int lane) {
    const int nblk = N / 32, kb = item / nblk, nb = item % nblk, k0 = 64 * kb, n0 = 32 * nb;
#pragma unroll 8
    for (int i = 0; i < 32; ++i) { const int kk = 2 * i + (lane >> 5); scr[kk * 33 + (lane & 31)] = W[(size_t)(k0 + kk) * N + n0 + (lane & 31)]; }
    asm volatile("s_waitcnt lgkmcnt(0)" ::: "memory");
    const int c = lane & 7;
#pragma unroll
    for (int j = 0; j < 4; ++j) { const int n = (lane >> 3) + 8 * j; const LAS float* s = scr + (8 * c) * 33 + n;
        u32x4 o; o.x = pk2(s[0 * 33], s[1 * 33]); o.y = pk2(s[2 * 33], s[3 * 33]); o.z = pk2(s[4 * 33], s[5 * 33]); o.w = pk2(s[6 * 33], s[7 * 33]);
        *(u32x4*)(WT + (size_t)(n0 + n) * K + k0 + 8 * c) = o; }
    asm volatile("s_waitcnt lgkmcnt(0)" ::: "memory");
}


#define XB_TMO      128
#define XB_XCNT(j)  (256  + 64 * (j))
#define XB_XSUB(j)  (1280 + 64 * (j))
#define XB_XGEN(j)  (2304 + 64 * (j))
#define XB_TOP      3328
#define XB_TOPGEN   3392
#define XCD_BAR_WORDS 3456
#define XB_SPIN_CAP (1u << 18)
__device__ __forceinline__ unsigned xb_ld(unsigned* p)              { return __hip_atomic_load(p, __ATOMIC_RELAXED, __HIP_MEMORY_SCOPE_AGENT); }
__device__ __forceinline__ unsigned xb_add(unsigned* p, unsigned v) { return __hip_atomic_fetch_add(p, v, __ATOMIC_RELAXED, __HIP_MEMORY_SCOPE_AGENT); }
__device__ __forceinline__ unsigned xb_xcc_id() { return (unsigned)__builtin_amdgcn_s_getreg((3 << 11) | 20) & 0xFu; }
#define XB_SPIN(cond, bar) do { unsigned _sp = 0; while (cond) { __builtin_amdgcn_s_sleep(1); \
    if ((++_sp & 255u) == 0u) { if (xb_ld(&(bar)[XB_TMO])) break; if (_sp > XB_SPIN_CAP) { atomicAdd(&(bar)[XB_TMO], 1u); break; } } } } while (0)
struct XcdBarrier { unsigned* bar; unsigned x; volatile LAS unsigned* st; };
__device__ __forceinline__ XcdBarrier xcd_barrier_post(unsigned* bar, volatile LAS unsigned* st) {
    XcdBarrier b; b.bar = bar; b.x = xb_xcc_id(); b.st = st;
    if (threadIdx.x == 0) (void)xb_add(&bar[XB_XCNT(b.x)], 1u);
    return b;
}
__device__ __forceinline__ void xcd_barrier_complete(unsigned* bar, unsigned x, unsigned& nloc, unsigned& nx) {
    const unsigned G = gridDim.x * gridDim.y * gridDim.z;
    unsigned sum, cnt, mine, sp = 0u;
    for (;;) {
        sum = 0u; cnt = 0u; mine = 0u;
#pragma unroll
        for (unsigned j = 0; j < 16; ++j) { const unsigned c = xb_ld(&bar[XB_XCNT(j)]); sum += c; cnt += (c > 0u) ? 1u : 0u; mine = (j == x) ? c : mine; }
        if (sum == G) break;
        __builtin_amdgcn_s_sleep(1);
        if ((++sp & 255u) == 0u) { if (xb_ld(&bar[XB_TMO])) break; if (sp > XB_SPIN_CAP) { atomicAdd(&bar[XB_TMO], 1u); break; } }
    }
    nloc = mine > 0u ? mine : 1u; nx = cnt > 0u ? cnt : 1u;
}
__device__ __forceinline__ void xcd_barrier(const XcdBarrier& b) {
    asm volatile("s_waitcnt vmcnt(0)" ::: "memory");
    __syncthreads();
    if (threadIdx.x == 0) {
        unsigned* bar = b.bar;
        __builtin_amdgcn_s_waitcnt(0);
        unsigned nloc = b.st[0], nx = b.st[1];
        if (nloc == 0u) { xcd_barrier_complete(bar, b.x, nloc, nx); b.st[0] = nloc; b.st[1] = nx; }
        const unsigned old = xb_add(&bar[XB_XSUB(b.x)], 1u);
        const unsigned gen = old / nloc;
        if (old + 1u == (gen + 1u) * nloc) {
            __builtin_amdgcn_fence(__ATOMIC_RELEASE, "agent");
            asm volatile("s_waitcnt vmcnt(0)" ::: "memory");
            const unsigned og = xb_add(&bar[XB_TOP], 1u);
            const unsigned tg = og / nx;
            if (og + 1u == (tg + 1u) * nx) xb_add(&bar[XB_TOPGEN], 1u);
            else XB_SPIN(xb_ld(&bar[XB_TOPGEN]) == tg, bar);
            __builtin_amdgcn_fence(__ATOMIC_ACQUIRE, "agent");
            xb_add(&bar[XB_XGEN(b.x)], 1u);
            asm volatile("s_waitcnt vmcnt(0)" ::: "memory");
        } else {
            XB_SPIN(xb_ld(&bar[XB_XGEN(b.x)]) == gen, bar);
            __builtin_amdgcn_fence(__ATOMIC_ACQUIRE, "agent");
            asm volatile("s_waitcnt vmcnt(0)" ::: "memory");
        }
    }
    __syncthreads();
}

struct Args { const float* in[18]; float* out; unsigned char* ws; };
#define GRID_SYNC() do { asm volatile("s_waitcnt vmcnt(0) lgkmcnt(0)" ::: "memory"); grid.sync(); } while (0)
#define XCD_SYNC() xcd_barrier(xbar)

__global__ void __launch_bounds__(512) fwd_megakernel(Args a) {
    extern __shared__ __attribute__((aligned(16))) unsigned char lds[];
    cg::grid_group grid = cg::this_grid();
    const int G = gridDim.x, bx = blockIdx.x, NGW = G * 8, NGT = G * 512;
#define PHASE_IDS() int tid_ = threadIdx.x; asm volatile("" : "+v"(tid_)); const int tid = tid_, lane = tid & 63, wave = __builtin_amdgcn_readfirstlane(tid >> 6), \
        gw = bx * 8 + wave, gt = bx * 512 + tid; (void)lane; (void)gw; (void)gt
    unsigned char* ws = a.ws;
    volatile LAS unsigned* xst = (volatile LAS unsigned*)((LAS unsigned char*)lds + (LDS_BYTES - 64));
    if (threadIdx.x < 2) xst[threadIdx.x] = 0u;
    __syncthreads();
    const XcdBarrier xbar = xcd_barrier_post((unsigned*)ws, xst);
    const float* x = a.in[0]; const float* w_in = a.in[1]; const float* b_gate = a.in[2]; const float* pool_w = a.in[3]; const float* pool_scale = a.in[4];
    const float* lq1 = a.in[5]; const float* lk1 = a.in[6]; const float* lq2 = a.in[7]; const float* lk2 = a.in[8]; const float* g_subln = a.in[9];
    const float* w_pool_out = a.in[10]; const float* w_attn_out = a.in[11]; const float* w_o = a.in[12]; const float* g_mix = a.in[13]; const float* g_mlp = a.in[14];
    const float* w_up = a.in[15]; const float* w_down = a.in[16]; const float* g_final = a.in[17];
    float* out = a.out;
    f32x2* ROPE = (f32x2*)(ws + WS_ROPE); float* RS1 = (float*)(ws + WS_RS1); float* RS2 = (float*)(ws + WS_RS2);
    bf16_t* WIN = (bf16_t*)(ws + WS_WIN); bf16_t* WATT = (bf16_t*)(ws + WS_WATT); bf16_t* WO = (bf16_t*)(ws + WS_WO); bf16_t* WUP = (bf16_t*)(ws + WS_WUP);
    bf16_t* WDN = (bf16_t*)(ws + WS_WDN); bf16_t* WCOMB = (bf16_t*)(ws + WS_WCOMB);
    bf16_t* H = (bf16_t*)(ws + WS_H); bf16_t* MP = (bf16_t*)(ws + WS_MP); bf16_t* QB = (bf16_t*)(ws + WS_Q); bf16_t* ATT = (bf16_t*)(ws + WS_ATT);
    bf16_t* KB = (bf16_t*)(ws + WS_K); bf16_t* MG = (bf16_t*)(ws + WS_MG); bf16_t* VB = (bf16_t*)(ws + WS_V); bf16_t* GT = (bf16_t*)(ws + WS_G); bf16_t* XG = (bf16_t*)(ws + WS_XG);
    bf16_t* UB = (bf16_t*)(ws + WS_U); bf16_t* PB = (bf16_t*)(ws + WS_P); bf16_t* HB = (bf16_t*)(ws + WS_HB);
    LAS unsigned char* ldsl = (LAS unsigned char*)lds;

    {
        PHASE_IDS();
        LAS float* scr = (LAS float*)(ldsl + wave * 16384);
        constexpr int I_IN = (DM / 64) * (INW / 32), I_AT = (DM / 64) * (DM / 32), I_O = I_AT, I_UP = (DM / 64) * (DFF / 32), I_DN = (DFF / 64) * (DM / 32);
        constexpr int NITEMS = I_IN + I_AT + I_O + I_UP + I_DN;
        for (int it = gw; it < NITEMS; it += NGW) {
            int r = it;
            if (r < I_IN) { transpose_item(w_in, DM, INW, WIN, scr, r, lane); continue; } r -= I_IN;
            if (r < I_AT) { transpose_item(w_attn_out, DM, DM, WATT, scr, r, lane); continue; } r -= I_AT;
            if (r < I_O) { transpose_item(w_o, DM, DM, WO, scr, r, lane); continue; } r -= I_O;
            if (r < I_UP) { transpose_item(w_up, DM, DFF, WUP, scr, r, lane); continue; } r -= I_UP;
            transpose_item(w_down, DFF, DM, WDN, scr, r, lane);
        }
        for (int wi = gw; wi < 1024; wi += NGW) {
            const int kk8 = wi >> 4, n = (wi & 15) * 64 + lane, g = kk8 >> 4, p0 = (kk8 & 15) * 8;
            float acc[8] = {0.f, 0.f, 0.f, 0.f, 0.f, 0.f, 0.f, 0.f};
            for (int q = 0; q < 128; ++q) {
                const int gq = g * 128 + q; const float wv = w_pool_out[(size_t)gq * DM + n] * pool_scale[gq];
#pragma unroll
                for (int j = 0; j < 8; ++j) acc[j] += pool_w[(size_t)(g * 128 + p0 + j) * 128 + q] * wv;
            }
            u32x4 o; o.x = pk2(acc[0], acc[1]); o.y = pk2(acc[2], acc[3]); o.z = pk2(acc[4], acc[5]); o.w = pk2(acc[6], acc[7]);
            *(u32x4*)(WCOMB + (size_t)n * POOLW + kk8 * 8) = o;
        }
        for (int e = gt; e < SEQ * 8; e += NGT) {
            const int pos = e >> 3, i = e & 7;
            const float inv = (i == 0) ? 1.0f : (i == 1) ? 0.1939227432012558f : (i == 2) ? 0.03760603070259094f : (i == 3) ? 0.007292664609849453f :
                              (i == 4) ? 0.0014142135623842478f : (i == 5) ? 0.00027424818836152554f : (i == 6) ? 5.3182957344688475e-05f : 1.0313385246263351e-05f;
            const float ang = (float)pos * inv;
            double rev = (double)ang * 0.15915494309189535; rev -= __builtin_rint(rev);
            const float rv = (float)rev;
            ROPE[e] = (f32x2){__builtin_amdgcn_cosf(rv), __builtin_amdgcn_sinf(rv)};
        }
        for (int m = gw; m < MTOK; m += NGW) {
            const f32x4* xr = (const f32x4*)(x + (size_t)m * DM) + lane;
            f32x4 v[4]; float s = 0.f;
#pragma unroll
            for (int j = 0; j < 4; ++j) { v[j] = xr[64 * j]; s += (v[j][0] * v[j][0] + v[j][1] * v[j][1]) + (v[j][2] * v[j][2] + v[j][3] * v[j][3]); }
            const float rstd = __builtin_amdgcn_rsqf(wave_sum(s) * (1.f / DM) + NORM_EPS);
            u32x2* o8 = (u32x2*)(H + (size_t)m * DM) + lane;
#pragma unroll
            for (int j = 0; j < 4; ++j) { const f32x4 gg = ((const f32x4*)g_mix)[lane + 64 * j]; const f32x4 w = v[j] * gg * rstd;
                u32x2 p; p.x = cvt_pk_bf16(w[0], w[1]); p.y = cvt_pk_bf16(w[2], w[3]); o8[64 * j] = p; }
        }
    }
    GRID_SYNC();

    {
        pg8::Gemm g{H, WIN, MTOK, INW, DM}; pg8::StaticOrder S; S.init(MTOK, INW, G, bx);
        pg8::EpiProj E{UB, QB, KB, VB, GT, b_gate, ROPE};
        pg8::gemm_phase<pg8::EpiProj, pg8::StaticOrder, true, true>(ldsl, g, S, E);
#if PROBE_DUP == 1
        __syncthreads(); pg8::gemm_phase<pg8::EpiProj, pg8::StaticOrder, true, true>(ldsl, g, S, E);
#endif
    }
    XCD_SYNC();

    {
        PHASE_IDS();
        for (int it = gt; it < MTOK * 64; it += NGT) {
            const int m = it >> 6, col = (it & 63) * 8, gi = col >> 7, w = 2 << gi, t = m & (SEQ - 1);
            const int n = (t + 1 < w) ? t + 1 : w;
            float acc[8] = {0.f, 0.f, 0.f, 0.f, 0.f, 0.f, 0.f, 0.f};
            const bf16_t* up = UB + (size_t)m * POOLW + col;
            const u32x4 cur = *(const u32x4*)up;
            for (int j = 0; j < n; ++j) {
                const u32x4 v = *(const u32x4*)(up - (size_t)j * POOLW);
                acc[0] += bf_lo(v.x); acc[1] += bf_hi(v.x); acc[2] += bf_lo(v.y); acc[3] += bf_hi(v.y);
                acc[4] += bf_lo(v.z); acc[5] += bf_hi(v.z); acc[6] += bf_lo(v.w); acc[7] += bf_hi(v.w);
            }
            const float rn = 1.0f / (float)n;
            u32x4 o;
            o.x = cvt_pk_bf16(acc[0] * rn - bf_lo(cur.x), acc[1] * rn - bf_hi(cur.x)); o.y = cvt_pk_bf16(acc[2] * rn - bf_lo(cur.y), acc[3] * rn - bf_hi(cur.y));
            o.z = cvt_pk_bf16(acc[4] * rn - bf_lo(cur.z), acc[5] * rn - bf_hi(cur.z)); o.w = cvt_pk_bf16(acc[6] * rn - bf_lo(cur.w), acc[7] * rn - bf_hi(cur.w));
            *(u32x4*)(PB + (size_t)m * POOLW + col) = o;
        }
        const int ln2 = lane;
        const float s1 = wave_sum(lq1[ln2] * lk1[ln2]), s2 = wave_sum(lq2[ln2] * lk2[ln2]);
        const float lam = __expf(s1) - __expf(s2) + LAMBDA_INIT;
        for (int p = bx; p < 64 * 32; p += G) {
            const int bh = (p >> 8) * 8 + (p & 7), pr = (p & 255) >> 3, b = bh >> 3, h = bh & 7;
            const bf16_t* Kh = KB + (size_t)bh * SEQ * 128; const bf16_t* Vh = VB + (size_t)bh * SEQ * 128;
#pragma unroll 1
            for (int uu = 0; uu < 2; ++uu) {
                const int qb = uu ? pr : 63 - pr, q0 = qb * 128;
                const size_t qoff = ((size_t)b * SEQ + q0) * DM + h * 128;
#if PROBE_DUP == 2
                att::attn_unit(QB + qoff, Kh, Vh, H + qoff, q0 + 128, lam, g_subln, (char*)lds);
#endif
                att::attn_unit(QB + qoff, Kh, Vh, ATT + qoff, q0 + 128, lam, g_subln, (char*)lds);
            }
        }
    }
    XCD_SYNC();

    {
        pg8::StaticOrder S; S.init(MTOK, DM, G, bx);
        { pg8::Gemm g{PB, WCOMB, MTOK, DM, POOLW}; pg8::EpiGate<false> E{GT, 0, nullptr, MP};
          pg8::gemm_phase<pg8::EpiGate<false>, pg8::StaticOrder, true, true>(ldsl, g, S, E); }
        __threadfence(); __syncthreads();
        { pg8::Gemm g{ATT, WATT, MTOK, DM, DM}; pg8::EpiGate<true> E{GT, DM, MP, MG};
          pg8::gemm_phase<pg8::EpiGate<true>, pg8::StaticOrder, true, true>(ldsl, g, S, E); }
    }
    XCD_SYNC();

    {
        pg8::Gemm g{MG, WO, MTOK, DM, DM}; pg8::StaticOrder S; S.init(MTOK, DM, G, bx);
        pg8::EpiRes<true> E{x, out, XG, g_mlp, RS1};
        pg8::gemm_phase<pg8::EpiRes<true>, pg8::StaticOrder, true, true>(ldsl, g, S, E);
    }
    XCD_SYNC();

    {
        pg8::Gemm g{XG, WUP, MTOK, DFF, DM}; pg8::StaticOrder S; S.init(MTOK, DFF, G, bx);
        pg8::EpiUp E{RS1, HB};
        pg8::gemm_phase<pg8::EpiUp, pg8::StaticOrder, true, true>(ldsl, g, S, E);
#if PROBE_DUP == 5
        __syncthreads(); pg8::gemm_phase<pg8::EpiUp, pg8::StaticOrder, true, true>(ldsl, g, S, E);
#endif
    }
    XCD_SYNC();

    {
        pg8::Gemm g{HB, WDN, MTOK, DM, DFF}; pg8::StaticOrder S; S.init(MTOK, DM, G, bx);
        pg8::EpiRes<false> E{out, out, nullptr, nullptr, RS2};
        pg8::gemm_phase<pg8::EpiRes<false>, pg8::StaticOrder, true, true>(ldsl, g, S, E);
    }
    XCD_SYNC();

    PHASE_IDS();
    const int ln7 = lane;
    for (int m = gw; m < MTOK; m += NGW) {
        float ps = (ln7 < 16) ? RS2[(size_t)m * 16 + ln7] : 0.f;
        ps = wave_sum(ps);
        const float rstd = __builtin_amdgcn_rsqf(ps * (1.f / DM) + NORM_EPS);
        f32x4* xr = (f32x4*)(out + (size_t)m * DM) + ln7;
#pragma unroll
        for (int j = 0; j < 4; ++j) { const f32x4 gg = ((const f32x4*)g_final)[ln7 + 64 * j]; xr[64 * j] = xr[64 * j] * gg * rstd; }
    }
}

extern "C" void kernel_launch(void* const* d_in, const int* in_sizes, int n_in, void* d_out, int out_size, void* d_ws, size_t ws_size, hipStream_t stream) {
    static int grid_blocks = 0;
    if (grid_blocks == 0) {
        if (n_in != 18 || in_sizes[0] != MTOK * DM || out_size != MTOK * DM || ws_size < WS_END) {
            fprintf(stderr, "kernel_launch: unexpected shapes: n_in %d in0 %d out %d ws %zu (need >= %zu)\n", n_in, n_in > 0 ? in_sizes[0] : -1, out_size, ws_size, (size_t)WS_END);
            grid_blocks = -1; return; }
        int dev = 0, cus = 0, per_cu = 0;
        hipGetDevice(&dev);
        hipDeviceGetAttribute(&cus, hipDeviceAttributeMultiprocessorCount, dev);
        if (hipFuncSetAttribute((const void*)fwd_megakernel, hipFuncAttributeMaxDynamicSharedMemorySize, LDS_BYTES) != hipSuccess) { fprintf(stderr, "kernel_launch: hipFuncSetAttribute failed\n"); grid_blocks = -1; return; }
        if (hipOccupancyMaxActiveBlocksPerMultiprocessor(&per_cu, (const void*)fwd_megakernel, 512, LDS_BYTES) != hipSuccess || per_cu < 1) { per_cu = 1; (void)hipGetLastError(); }
        grid_blocks = cus * per_cu;
    }
    if (grid_blocks < 0) return;
    if (hipMemsetAsync(d_ws, 0, 16384, stream) != hipSuccess) { fprintf(stderr, "kernel_launch: hipMemsetAsync failed\n"); return; }
    Args a{};
    for (int i = 0; i < 18; ++i) a.in[i] = (const float*)d_in[i];
    a.out = (float*)d_out; a.ws = (unsigned char*)d_ws;
    void* args[] = {&a};
    hipError_t e = hipLaunchCooperativeKernel((const void*)fwd_megakernel, dim3(grid_blocks), dim3(512), args, LDS_BYTES, stream);
    if (e != hipSuccess) fprintf(stderr, "cooperative launch failed: %s (grid %d)\n", hipGetErrorString(e), grid_blocks);
}
```
